# Optimizing an MI355X kernel written in HIP

```python
import math
import jax, jax.numpy as jnp
from jax import lax
import numpy as np

D_MODEL = 1024
BATCH = 8
SEQ = 4096
DEPTH = 4

GRID_W = 64
Q_BLOCK = 128
NORM_EPS = 1e-6
D_FF = 4 * D_MODEL
MLA_HEADS = 8
MLA_NOPE = 64
MLA_ROPE = 32
MLA_V = 64
MLA_Q_RANK = 384
MLA_KV_RANK = 256
ROPE_THETA = 10000.0
NA_HEADS = 8
NA_HEAD_DIM = 64
NA_ROWS = 8
NA_COLS = 16
NA_W = NA_HEADS * NA_HEAD_DIM
DIFF_HEADS = 8
DIFF_HEAD_DIM = 64
DIFF_W = DIFF_HEADS * 2 * DIFF_HEAD_DIM
T5_BUCKETS = 32
T5_MAX_DIST = 128

AB_IN = MLA_Q_RANK + MLA_KV_RANK + MLA_ROPE + 3 * NA_W
AB_OUT = MLA_HEADS * MLA_V + NA_W
C_IN = 3 * DIFF_W
N_EVEN = (DEPTH + 1) // 2
N_ODD = DEPTH // 2

kernel_name = "hybrid_mla_natten_diffattn_encoder"


def _rmsnorm(x, g):
    xf = x.astype(jnp.float32)
    y = xf * lax.rsqrt(jnp.mean(xf * xf, axis=-1, keepdims=True) + NORM_EPS)
    return (y * g.astype(jnp.float32)).astype(x.dtype)


def _rope_tables(S):
    inv_freq = ROPE_THETA ** (-jnp.arange(0, MLA_ROPE, 2, dtype=jnp.float32) / MLA_ROPE)
    ang = jnp.arange(S, dtype=jnp.float32)[:, None] * inv_freq[None, :]
    return jnp.cos(ang), jnp.sin(ang)


def _rope(x, cos, sin):
    c = cos[None, :, None, :].astype(x.dtype)
    s = sin[None, :, None, :].astype(x.dtype)
    x1, x2 = jnp.split(x, 2, axis=-1)
    return jnp.concatenate([x1 * c - x2 * s, x2 * c + x1 * s], axis=-1)


def _t5_bucket(rel):
    nb = T5_BUCKETS // 2
    max_exact = nb // 2
    ret = jnp.where(rel > 0, nb, 0)
    n = jnp.abs(rel)
    nf = jnp.maximum(n, 1).astype(jnp.float32)
    large = max_exact + (jnp.log(nf / max_exact) / math.log(T5_MAX_DIST / max_exact)
                         * (nb - max_exact)).astype(jnp.int32)
    large = jnp.minimum(large, nb - 1)
    return ret + jnp.where(n < max_exact, n, large)


def _dense_attention(q, k, v):
    B, S, H, Dq = q.shape
    nb = S // Q_BLOCK
    qb = q.reshape(B, nb, Q_BLOCK, H, Dq).swapaxes(0, 1)
    scale = Dq ** -0.5

    def one(qblk):
        s = jnp.einsum('bqhd,bkhd->bhqk', qblk, k).astype(jnp.float32) * scale
        p = jax.nn.softmax(s, axis=-1)
        return jnp.einsum('bhqk,bkhd->bqhd', p.astype(v.dtype), v)

    out = lax.map(one, qb)
    return out.swapaxes(0, 1).reshape(B, S, H, v.shape[-1])


def _neighborhood_attention(q, k, v, rpb):
    B, S, H, D = q.shape
    rows = S // GRID_W
    kh = min(NA_ROWS, rows)
    qg = q.reshape(B, rows, GRID_W, H, D)
    kg = k.reshape(B, rows, GRID_W, H, D)
    vg = v.reshape(B, rows, GRID_W, H, D)
    cols = np.arange(GRID_W)
    col_start = np.clip(cols - NA_COLS // 2, 0, GRID_W - NA_COLS)
    col_idx = col_start[:, None] + np.arange(NA_COLS)[None, :]
    dc = col_idx - cols[:, None] + NA_COLS - 1
    rpb_cols = rpb[:, :, dc]
    scale = D ** -0.5

    def one(r):
        rs = jnp.clip(r - kh // 2, 0, rows - kh)
        k_rows = lax.dynamic_slice_in_dim(kg, rs, kh, axis=1)
        v_rows = lax.dynamic_slice_in_dim(vg, rs, kh, axis=1)
        k_win = k_rows[:, :, col_idx]
        v_win = v_rows[:, :, col_idx]
        q_row = lax.dynamic_index_in_dim(qg, r, axis=1, keepdims=False)
        s = jnp.einsum('bwhd,bkwjhd->bhwkj', q_row, k_win).astype(jnp.float32) * scale
        dr = rs + jnp.arange(kh) - r + NA_ROWS - 1
        bias = jnp.take(rpb_cols, dr, axis=1).astype(jnp.float32)
        s = s + jnp.transpose(bias, (0, 2, 1, 3))[None]
        p = jax.nn.softmax(s.reshape(B, H, GRID_W, kh * NA_COLS), axis=-1)
        p = p.reshape(B, H, GRID_W, kh, NA_COLS).astype(v.dtype)
        return jnp.einsum('bhwkj,bkwjhd->bwhd', p, v_win)

    out = lax.map(one, jnp.arange(rows))
    return out.swapaxes(0, 1).reshape(B, S, H, D)


def _diff_attention(q1, q2, k1, k2, v, lam, t5_table):
    B, S, H, D = q1.shape
    nb = S // Q_BLOCK
    kpos = jnp.arange(S)
    scale = D ** -0.5

    def blocks(t):
        return t.reshape(B, nb, Q_BLOCK, H, D).swapaxes(0, 1)

    def one(args):
        q1b, q2b, blk = args
        qpos = blk * Q_BLOCK + jnp.arange(Q_BLOCK)
        bias = t5_table[_t5_bucket(kpos[None, :] - qpos[:, None])].astype(jnp.float32)
        bias = jnp.transpose(bias, (2, 0, 1))[None]
        s1 = jnp.einsum('bqhd,bkhd->bhqk', q1b, k1).astype(jnp.float32) * scale + bias
        s2 = jnp.einsum('bqhd,bkhd->bhqk', q2b, k2).astype(jnp.float32) * scale + bias
        p = jax.nn.softmax(s1, axis=-1) - lam * jax.nn.softmax(s2, axis=-1)
        return jnp.einsum('bhqk,bkhd->bqhd', p.astype(v.dtype), v)

    out = lax.map(one, (blocks(q1), blocks(q2), jnp.arange(nb)))
    return out.swapaxes(0, 1).reshape(B, S, H, v.shape[-1])


def _mla_natten_mixer(h, w_in, q_norm, w_uq, kv_norm, w_ukv, rpb, w_out, cos, sin):
    B, S, _ = h.shape
    proj = h @ w_in
    offs = np.cumsum([MLA_Q_RANK, MLA_KV_RANK, MLA_ROPE, NA_W, NA_W]).tolist()
    c_q, c_kv, k_pe, q_na, k_na, v_na = jnp.split(proj, offs, axis=-1)
    q = (_rmsnorm(c_q, q_norm) @ w_uq).reshape(B, S, MLA_HEADS, MLA_NOPE + MLA_ROPE)
    q_nope, q_pe = q[..., :MLA_NOPE], q[..., MLA_NOPE:]
    kv = (_rmsnorm(c_kv, kv_norm) @ w_ukv).reshape(B, S, MLA_HEADS, MLA_NOPE + MLA_V)
    k_nope, v = kv[..., :MLA_NOPE], kv[..., MLA_NOPE:]
    q_pe = _rope(q_pe, cos, sin)
    k_pe = jnp.broadcast_to(_rope(k_pe[:, :, None, :], cos, sin), (B, S, MLA_HEADS, MLA_ROPE))
    o_a = _dense_attention(jnp.concatenate([q_nope, q_pe], axis=-1),
                           jnp.concatenate([k_nope, k_pe], axis=-1), v)
    shp = (B, S, NA_HEADS, NA_HEAD_DIM)
    o_b = _neighborhood_attention(q_na.reshape(shp), k_na.reshape(shp), v_na.reshape(shp), rpb)
    o = jnp.concatenate([o_a.reshape(B, S, MLA_HEADS * MLA_V), o_b.reshape(B, S, NA_W)], axis=-1)
    return o @ w_out


def _diff_mixer(h, w_in, lq1, lk1, lq2, lk2, subln, w_out, t5_table, lambda_init):
    B, S, _ = h.shape
    q, k, v = jnp.split(h @ w_in, [DIFF_W, 2 * DIFF_W], axis=-1)
    q = q.reshape(B, S, DIFF_HEADS, 2, DIFF_HEAD_DIM)
    k = k.reshape(B, S, DIFF_HEADS, 2, DIFF_HEAD_DIM)
    v = v.reshape(B, S, DIFF_HEADS, 2 * DIFF_HEAD_DIM)
    f32 = jnp.float32
    lam = (jnp.exp(jnp.sum(lq1.astype(f32) * lk1.astype(f32)))
           - jnp.exp(jnp.sum(lq2.astype(f32) * lk2.astype(f32))) + lambda_init)
    o = _diff_attention(q[..., 0, :], q[..., 1, :], k[..., 0, :], k[..., 1, :], v, lam, t5_table)
    o = _rmsnorm(o, subln) * (1.0 - lambda_init)
    return o.reshape(B, S, DIFF_W) @ w_out


def _sq_relu_mlp(h, w1, w2):
    a = jax.nn.relu(h @ w1)
    return (a * a) @ w2


def _normal(key, shape, scale):
    return scale * jax.random.normal(key, shape, jnp.float32)


def setup_inputs(seed: int = 0) -> dict:
    key = jax.random.key(seed)
    ks = jax.random.split(key, 24)
    D = D_MODEL
    return {
        "x": _normal(ks[0], (BATCH, SEQ, D), 1.0),
        "norm_attn": 1.0 + _normal(ks[1], (DEPTH, D), 0.02),
        "norm_mlp": 1.0 + _normal(ks[2], (DEPTH, D), 0.02),
        "ab_w_in": _normal(ks[3], (N_EVEN, D, AB_IN), D ** -0.5),
        "ab_q_norm": 1.0 + _normal(ks[4], (N_EVEN, MLA_Q_RANK), 0.02),
        "ab_w_uq": _normal(ks[5], (N_EVEN, MLA_Q_RANK, MLA_HEADS * (MLA_NOPE + MLA_ROPE)), MLA_Q_RANK ** -0.5),
        "ab_kv_norm": 1.0 + _normal(ks[6], (N_EVEN, MLA_KV_RANK), 0.02),
        "ab_w_ukv": _normal(ks[7], (N_EVEN, MLA_KV_RANK, MLA_HEADS * (MLA_NOPE + MLA_V)), MLA_KV_RANK ** -0.5),
        "ab_natten_rpb": _normal(ks[8], (N_EVEN, NA_HEADS, 2 * NA_ROWS - 1, 2 * NA_COLS - 1), 0.1),
        "ab_w_out": _normal(ks[9], (N_EVEN, AB_OUT, D), AB_OUT ** -0.5),
        "c_w_in": _normal(ks[10], (N_ODD, D, C_IN), D ** -0.5),
        "c_lambda_q1": _normal(ks[11], (N_ODD, DIFF_HEAD_DIM), 0.1),
        "c_lambda_k1": _normal(ks[12], (N_ODD, DIFF_HEAD_DIM), 0.1),
        "c_lambda_q2": _normal(ks[13], (N_ODD, DIFF_HEAD_DIM), 0.1),
        "c_lambda_k2": _normal(ks[14], (N_ODD, DIFF_HEAD_DIM), 0.1),
        "c_subln": 1.0 + _normal(ks[15], (N_ODD, 2 * DIFF_HEAD_DIM), 0.02),
        "c_w_out": _normal(ks[16], (N_ODD, DIFF_W, D), DIFF_W ** -0.5),
        "t5_bias": _normal(ks[17], (T5_BUCKETS, DIFF_HEADS), 0.5),
        "mlp_w1": _normal(ks[18], (DEPTH, D, D_FF), D ** -0.5),
        "mlp_w2": _normal(ks[19], (DEPTH, D_FF, D), D_FF ** -0.5),
        "final_norm": 1.0 + _normal(ks[20], (D,), 0.02),
    }


def reference(x, norm_attn, norm_mlp, ab_w_in, ab_q_norm, ab_w_uq, ab_kv_norm, ab_w_ukv,
              ab_natten_rpb, ab_w_out, c_w_in, c_lambda_q1, c_lambda_k1, c_lambda_q2,
              c_lambda_k2, c_subln, c_w_out, t5_bias, mlp_w1, mlp_w2, final_norm):
    S = x.shape[1]
    cos, sin = _rope_tables(S)
    for layer in range(DEPTH):
        i = layer // 2
        h = _rmsnorm(x, norm_attn[layer])
        if layer % 2 == 0:
            mix = _mla_natten_mixer(h, ab_w_in[i], ab_q_norm[i], ab_w_uq[i], ab_kv_norm[i],
                                    ab_w_ukv[i], ab_natten_rpb[i], ab_w_out[i], cos, sin)
        else:
            lambda_init = 0.8 - 0.6 * math.exp(-0.3 * layer)
            mix = _diff_mixer(h, c_w_in[i], c_lambda_q1[i], c_lambda_k1[i], c_lambda_q2[i],
                              c_lambda_k2[i], c_subln[i], c_w_out[i], t5_bias, lambda_init)
        x = x + mix
        h = _rmsnorm(x, norm_mlp[layer])
        x = x + _sq_relu_mlp(h, mlp_w1[layer], mlp_w2[layer])
    return _rmsnorm(x, final_norm)
```

```cpp
#include <hip/hip_runtime.h>
#include <hip/hip_cooperative_groups.h>
#include <cstdio>
namespace cg = cooperative_groups;

typedef unsigned short u16;
using bf16x8 = __attribute__((ext_vector_type(8))) short;
using s16x4  = __attribute__((ext_vector_type(4))) short;
using f32x4  = __attribute__((ext_vector_type(4))) float;
using f32x16 = __attribute__((ext_vector_type(16))) float;
using u32x4  = __attribute__((ext_vector_type(4))) unsigned;
using u32x2  = __attribute__((ext_vector_type(2))) unsigned;
typedef __bf16 bf2_t __attribute__((ext_vector_type(2)));
typedef float  fl2_t __attribute__((ext_vector_type(2)));
#define DI __device__ __forceinline__

#ifndef MULTI_LAUNCH
#define MULTI_LAUNCH 0
#endif

constexpr int T_ = 32768;
constexpr int S_ = 4096;
constexpr float LOG2E = 1.4426950408889634f;
constexpr float EPS = 1e-6f;
constexpr int NPH = 34;
constexpr int NTHR = 512;

constexpr size_t W_ABIN  = 0;
constexpr size_t W_UQ    = W_ABIN  + 2ull * 2304 * 1024 * 2;
constexpr size_t W_UKV   = W_UQ    + 2ull * 768 * 384 * 2;
constexpr size_t W_ABOUT = W_UKV   + 2ull * 1024 * 256 * 2;
constexpr size_t W_CIN   = W_ABOUT + 2ull * 1024 * 1024 * 2;
constexpr size_t W_COUT  = W_CIN   + 2ull * 3072 * 1024 * 2;
constexpr size_t W_W1    = W_COUT  + 2ull * 1024 * 1024 * 2;
constexpr size_t W_W2    = W_W1    + 4ull * 4096 * 1024 * 2;
constexpr size_t TB_COS  = W_W2    + 4ull * 4096 * 1024 * 2;
constexpr size_t TB_SIN  = TB_COS  + 4096ull * 16 * 4;
constexpr size_t TB_T5   = TB_SIN  + 4096ull * 16 * 4;
constexpr size_t TB_LAM  = TB_T5   + 8ull * 512 * 4;
constexpr size_t TB_SSA  = TB_LAM  + 256;
constexpr size_t TB_SSM  = TB_SSA  + (size_t)T_ * 16 * 4;
constexpr size_t TB_BAR  = TB_SSM  + (size_t)T_ * 16 * 4;
constexpr size_t B_H     = TB_BAR  + 16384;
constexpr size_t B_BIG   = B_H     + (size_t)T_ * 1024 * 2;
constexpr size_t E_CQ    = 0;
constexpr size_t E_CKV   = E_CQ    + (size_t)T_ * 384 * 2;
constexpr size_t E_KPE   = E_CKV   + (size_t)T_ * 256 * 2;
constexpr size_t E_QNA   = E_KPE   + (size_t)T_ * 32 * 2;
constexpr size_t E_KNA   = E_QNA   + (size_t)T_ * 512 * 2;
constexpr size_t E_VNAT  = E_KNA   + (size_t)T_ * 512 * 2;
constexpr size_t E_QMLA  = E_VNAT  + (size_t)T_ * 512 * 2;
constexpr size_t E_KNOPE = E_QMLA  + (size_t)T_ * 768 * 2;
constexpr size_t E_VMLAT = E_KNOPE + (size_t)T_ * 512 * 2;
constexpr size_t E_END   = E_VMLAT + (size_t)T_ * 512 * 2;
static_assert(E_END <= (size_t)T_ * 4096 * 2, "even buffers exceed BIG");
constexpr size_t O_QD    = 0;
constexpr size_t O_KD    = O_QD + (size_t)T_ * 1024 * 2;
constexpr size_t O_VDT   = O_KD + (size_t)T_ * 1024 * 2;
constexpr size_t B_XR    = B_BIG + (size_t)T_ * 4096 * 2;
constexpr size_t WS_NEED = B_XR + (size_t)T_ * 1024 * 2;

struct Params {
  const float* x; const float* norm_attn; const float* norm_mlp; const float* ab_w_in; const float* ab_q_norm;
  const float* ab_w_uq; const float* ab_kv_norm; const float* ab_w_ukv; const float* ab_rpb; const float* ab_w_out;
  const float* c_w_in; const float* lq1; const float* lk1; const float* lq2; const float* lk2; const float* c_subln;
  const float* c_w_out; const float* t5; const float* mlp_w1; const float* mlp_w2; const float* final_norm;
  float* xres; char* ws;
};

DI unsigned pack2(float a, float b) {
  fl2_t f = {a, b};
  bf2_t r = __builtin_convertvector(f, bf2_t);
  return __builtin_bit_cast(unsigned, r);
}
DI u16 f2bf(float x) { unsigned u = __float_as_uint(x); u += 0x7fffu + ((u >> 16) & 1u); return (u16)(u >> 16); }
DI float bf2f(unsigned v) { return __uint_as_float(v << 16); }
DI void st_bf4(u16* p, f32x4 v, float sc) {
  u32x2 u; u.x = pack2(v[0] * sc, v[1] * sc); u.y = pack2(v[2] * sc, v[3] * sc);
  *(u32x2*)p = u;
}
DI void st_bf8(u16* p, f32x4 a, f32x4 b, float sc) {
  u32x4 u; u.x = pack2(a[0] * sc, a[1] * sc); u.y = pack2(a[2] * sc, a[3] * sc); u.z = pack2(b[0] * sc, b[1] * sc); u.w = pack2(b[2] * sc, b[3] * sc);
  *(u32x4*)p = u;
}
DI void st_T(u16* p, f32x4 v, float sc) {
#pragma unroll
  for (int i = 0; i < 4; ++i) p[(size_t)i * S_] = f2bf(v[i] * sc);
}
DI int get_tid() { int t = threadIdx.x; asm volatile("" : "+v"(t)); return t; }
DI float shx(float v, int mask, int lane) {
  return __int_as_float(__builtin_amdgcn_ds_bpermute((lane ^ mask) << 2, __float_as_int(v)));
}
DI float wave_sum(float v, int lane) {
#pragma unroll
  for (int o = 32; o > 0; o >>= 1) v += shx(v, o, lane);
  return v;
}
DI f32x16 mfma32(bf16x8 a, bf16x8 b, f32x16 c) { return __builtin_amdgcn_mfma_f32_32x32x16_bf16(a, b, c, 0, 0, 0); }
DI f32x4 mfma16(bf16x8 a, bf16x8 b, f32x4 c) { return __builtin_amdgcn_mfma_f32_16x16x32_bf16(a, b, c, 0, 0, 0); }
DI bf16x8 pack8(const f32x16& s, int o) {
  u32x4 u;
  u.x = pack2(s[o + 0], s[o + 1]); u.y = pack2(s[o + 2], s[o + 3]);
  u.z = pack2(s[o + 4], s[o + 5]); u.w = pack2(s[o + 6], s[o + 7]);
  return __builtin_bit_cast(bf16x8, u);
}

DI void prep_wt(const float* __restrict__ src, u16* __restrict__ dst, int K, int N, int Npad,
                const float* __restrict__ gain, float* tile) {
  const int tid = get_tid();
  const int tk = K / 64, tn = Npad / 64, nt4 = tk * tn;
  constexpr int TS = 64 * 65;
  for (int t0 = blockIdx.x; t0 < nt4; t0 += 4 * gridDim.x) {
    f32x4 v[4][2];
#pragma unroll
    for (int j = 0; j < 4; ++j) {
      const int t = t0 + j * gridDim.x;
      const int kt = t % tk, nt = t / tk;
#pragma unroll
      for (int i = 0; i < 2; ++i) {
        const int e = tid + NTHR * i; const int kk = e >> 4, n4 = (e & 15) * 4; const int n = nt * 64 + n4;
        v[j][i] = (f32x4){0.f, 0.f, 0.f, 0.f};
        if (t < nt4 && n < N) {
          v[j][i] = *(const f32x4*)(src + (size_t)(kt * 64 + kk) * N + n);
          if (gain) v[j][i] *= gain[kt * 64 + kk];
        }
      }
    }
    __syncthreads();
#pragma unroll
    for (int j = 0; j < 4; ++j)
#pragma unroll
      for (int i = 0; i < 2; ++i) {
        const int e = tid + NTHR * i; const int kk = e >> 4, n4 = (e & 15) * 4;
        float* tp = tile + j * TS + kk * 65 + n4;
        tp[0] = v[j][i][0]; tp[1] = v[j][i][1]; tp[2] = v[j][i][2]; tp[3] = v[j][i][3];
      }
    __syncthreads();
#pragma unroll
    for (int j = 0; j < 4; ++j) {
      const int t = t0 + j * gridDim.x;
      if (t < nt4) {
        const int kt = t % tk, nt = t / tk;
        const int nn = tid >> 3, k8 = (tid & 7) * 8;
        const float* tp = tile + j * TS + k8 * 65 + nn;
        u32x4 u;
        u.x = pack2(tp[0 * 65], tp[1 * 65]); u.y = pack2(tp[2 * 65], tp[3 * 65]);
        u.z = pack2(tp[4 * 65], tp[5 * 65]); u.w = pack2(tp[6 * 65], tp[7 * 65]);
        *(u32x4*)(dst + (size_t)(nt * 64 + nn) * K + kt * 64 + k8) = u;
      }
    }
  }
}

DI int t5_bucket(int rel) {
  int ret = rel > 0 ? 16 : 0;
  int n = rel < 0 ? -rel : rel;
  int b;
  if (n < 8) b = n;
  else { int lg = 31 - __clz(n * n); b = 8 + lg - 6; if (b > 15) b = 15; }
  return ret + b;
}

DI void phase_prep(const Params& p, char* smem) {
  float* tile = (float*)smem;
  char* ws = p.ws;
  for (int i = 0; i < 2; ++i) {
    prep_wt(p.ab_w_in + (size_t)i * 1024 * 2208, (u16*)(ws + W_ABIN) + (size_t)i * 2304 * 1024, 1024, 2208, 2304, p.norm_attn + (2 * i) * 1024, tile);
    prep_wt(p.ab_w_uq + (size_t)i * 384 * 768, (u16*)(ws + W_UQ) + (size_t)i * 768 * 384, 384, 768, 768, p.ab_q_norm + i * 384, tile);
    prep_wt(p.ab_w_ukv + (size_t)i * 256 * 1024, (u16*)(ws + W_UKV) + (size_t)i * 1024 * 256, 256, 1024, 1024, p.ab_kv_norm + i * 256, tile);
    prep_wt(p.ab_w_out + (size_t)i * 1024 * 1024, (u16*)(ws + W_ABOUT) + (size_t)i * 1024 * 1024, 1024, 1024, 1024, nullptr, tile);
    prep_wt(p.c_w_in + (size_t)i * 1024 * 3072, (u16*)(ws + W_CIN) + (size_t)i * 3072 * 1024, 1024, 3072, 3072, p.norm_attn + (2 * i + 1) * 1024, tile);
    prep_wt(p.c_w_out + (size_t)i * 1024 * 1024, (u16*)(ws + W_COUT) + (size_t)i * 1024 * 1024, 1024, 1024, 1024, nullptr, tile);
  }
  for (int i = 0; i < 4; ++i) {
    prep_wt(p.mlp_w1 + (size_t)i * 1024 * 4096, (u16*)(ws + W_W1) + (size_t)i * 4096 * 1024, 1024, 4096, 4096, p.norm_mlp + i * 1024, tile);
    prep_wt(p.mlp_w2 + (size_t)i * 4096 * 1024, (u16*)(ws + W_W2) + (size_t)i * 1024 * 4096, 4096, 1024, 1024, nullptr, tile);
  }
  {
    const int t0 = get_tid(); const int wave = t0 >> 6, lane = t0 & 63;
    u16* xb = (u16*)(ws + B_XR); float* ssa = (float*)(ws + TB_SSA);
    for (int row = blockIdx.x * 8 + wave; row < T_; row += gridDim.x * 8) {
      const f32x4* xr = (const f32x4*)(p.x + (size_t)row * 1024);
      float ss = 0.f;
#pragma unroll
      for (int i = 0; i < 2; ++i) {
        const f32x4 a = xr[2 * lane + 128 * i], b = xr[2 * lane + 128 * i + 1];
        ss += a[0] * a[0] + a[1] * a[1] + a[2] * a[2] + a[3] * a[3] + b[0] * b[0] + b[1] * b[1] + b[2] * b[2] + b[3] * b[3];
        st_bf8(xb + (size_t)row * 1024 + 8 * lane + 512 * i, a, b, 1.f);
      }
      ss = wave_sum(ss, lane);
      if (lane < 16) ssa[(size_t)row * 16 + lane] = (lane == 0) ? ss : 0.f;
    }
  }
  const int gt = blockIdx.x * NTHR + get_tid(), gn = gridDim.x * NTHR;
  float* tcos = (float*)(ws + TB_COS); float* tsin = (float*)(ws + TB_SIN);
  for (int idx = gt; idx < 4096 * 16; idx += gn) {
    int pos = idx >> 4, j = idx & 15;
    float inv = exp2f(-(float)j * (13.287712379549449f / 16.0f));
    float ang = (float)pos * inv;
    tcos[idx] = cosf(ang);
    tsin[idx] = sinf(ang);
  }
  float* t5t = (float*)(ws + TB_T5);
  for (int idx = gt; idx < 8 * 512; idx += gn) {
    int h = idx >> 9, e = idx & 511; int rel = e - 255; if (rel > 255) rel = 255;
    t5t[idx] = p.t5[t5_bucket(rel) * 8 + h] * LOG2E;
  }
  if (gt < 2) {
    float s1 = 0.f, s2 = 0.f;
    for (int d = 0; d < 64; ++d) { s1 += p.lq1[gt * 64 + d] * p.lk1[gt * 64 + d]; s2 += p.lq2[gt * 64 + d] * p.lk2[gt * 64 + d]; }
    int layer = 2 * gt + 1;
    float li = 0.8f - 0.6f * expf(-0.3f * (float)layer);
    ((float*)(ws + TB_LAM))[gt] = expf(s1) - expf(s2) + li;
  }
}

template <bool FINAL, bool IN_BF16>
DI void phase_norm(const void* __restrict__ xin, const float* __restrict__ g, u16* __restrict__ h, float* __restrict__ outf) {
  const int tid = get_tid();
  const int wave = tid >> 6, lane = tid & 63;
  for (int row = blockIdx.x * 8 + wave; row < T_; row += gridDim.x * 8) {
    f32x4 v[4]; float ss = 0.f;
    if (IN_BF16) {
      const u32x4* xr = (const u32x4*)((const u16*)xin + (size_t)row * 1024);
#pragma unroll
      for (int i = 0; i < 2; ++i) {
        const u32x4 u = xr[lane + 64 * i];
        v[2 * i]     = (f32x4){bf2f(u.x & 0xffffu), bf2f(u.x >> 16), bf2f(u.y & 0xffffu), bf2f(u.y >> 16)};
        v[2 * i + 1] = (f32x4){bf2f(u.z & 0xffffu), bf2f(u.z >> 16), bf2f(u.w & 0xffffu), bf2f(u.w >> 16)};
      }
    } else {
      const f32x4* xr = (const f32x4*)((const float*)xin + (size_t)row * 1024);
#pragma unroll
      for (int i = 0; i < 2; ++i) { v[2 * i] = xr[2 * lane + 128 * i]; v[2 * i + 1] = xr[2 * lane + 128 * i + 1]; }
    }
#pragma unroll
    for (int i = 0; i < 4; ++i) ss += v[i][0] * v[i][0] + v[i][1] * v[i][1] + v[i][2] * v[i][2] + v[i][3] * v[i][3];
    ss = wave_sum(ss, lane);
    const float rinv = rsqrtf(ss * (1.f / 1024.f) + EPS);
#pragma unroll
    for (int i = 0; i < 2; ++i) {
      const f32x4 g0 = ((const f32x4*)g)[2 * lane + 128 * i], g1 = ((const f32x4*)g)[2 * lane + 128 * i + 1];
      const f32x4 a = v[2 * i] * g0 * rinv, b = v[2 * i + 1] * g1 * rinv;
      if (FINAL) {
        f32x4* op = (f32x4*)(outf + (size_t)row * 1024);
        op[2 * lane + 128 * i] = a; op[2 * lane + 128 * i + 1] = b;
      } else {
        st_bf8(h + (size_t)row * 1024 + 8 * lane + 512 * i, a, b, 1.f);
      }
    }
  }
}

constexpr int SM_ATT_V = 17408;
constexpr int SM_ATT_TAB = 17408 + 64 * 320;
constexpr int STAGE_LDS = 131072;
constexpr int SM_RINVTAB = STAGE_LDS;
constexpr int ATT_LDS = 2 * (128 * 272 + 128 * 320) + 2048;
constexpr int SM_BARST = ATT_LDS;
constexpr int SMEM_BYTES = ATT_LDS + 16;
static_assert(ATT_LDS >= STAGE_LDS + 4096, "LDS map");
constexpr int ATT_HALF = 45056;
#define LAS __attribute__((address_space(3)))

namespace pg8 {
constexpr int BM = 256, BK = 64, HALF = 128, HTB = HALF * BK * 2, NXCD = 8, WGM = 8;
DI int lds_byte(int r, int c) { const int st = (r >> 4) * 2 + (c >> 5), rr = r & 15, cc = c & 31, ob = rr * 64 + cc * 2; return st * 1024 + (ob ^ (((ob >> 9) & 1) << 5)); }
DI void stage_rc(int b, int& R, int& C) { const int st = b / 1024, sb = b % 1024, swz = sb ^ (((sb >> 9) & 1) << 5); R = (st >> 1) * 16 + swz / 64; C = (st & 1) * 32 + (swz % 64) / 2; }
DI int perm32(int rho) { const int n = rho >> 4, i = rho & 15; return 8 * (i >> 2) + 4 * n + (i & 3); }
struct Unit { int pm, pn; };
struct Gemm { const u16* A; const u16* Bt; int M, N, K; };
struct StaticOrder {
  int nM, nN, nwg, G, c, rev;
  DI void init(int M, int N, int G_, int c_) { nM = M / BM; nN = N / BM; nwg = nM * nN; G = G_; c = c_; rev = 0; }
  DI bool next(int i, Unit& u) const {
    if ((long)i * G + c >= nwg) return false;
    const int ii = (rev && (nwg % G) == 0) ? (nwg / G - 1 - i) : i;
    const long L = (long)ii * G + c;
    int wgid = (int)L; { const int q = nwg / NXCD, r = nwg % NXCD, xcd = wgid % NXCD, off = wgid / NXCD; wgid = (xcd < r ? xcd * (q + 1) : r * (q + 1) + (xcd - r) * q) + off; }
    const int nig = WGM * nN, gid = wgid / nig, fm = gid * WGM, gsz = (nM - fm) < WGM ? (nM - fm) : WGM;
    u.pm = fm + ((wgid % nig) % gsz); u.pn = (wgid % nig) / gsz; return true;
  }
};

template <class Epi, class Sched>
DI void gemm_phase(LAS unsigned char* lds, const Gemm g, const Sched& S, const Epi& E) {
  const int tid = get_tid(), wid = __builtin_amdgcn_readfirstlane(tid >> 6), lane = tid & 63, wr = wid >> 2, wc = wid & 3, fr = lane & 15, fq = lane >> 4;
  const int K = g.K, nt = K / BK;
  unsigned voffA[2], voffB[2];
#pragma unroll
  for (int i = 0; i < 2; ++i) { int R, C; stage_rc(tid * 16 + i * 8192, R, C); const int Rb = Epi::PERM ? ((R & ~31) + perm32(R & 31)) : R;
    voffA[i] = (unsigned)(R * K + C) * 2u; voffB[i] = (unsigned)(Rb * K + C) * 2u; }
  const size_t kstep = (size_t)(BK * 2);
  const size_t hstep = (size_t)HALF * K * 2;
  const size_t tstep = 2 * hstep;
  const unsigned ldsw = (unsigned)wid * 1024u;
  const int aoff = lds_byte(wr * 64 + fr, fq * 8), boff = lds_byte(wc * 32 + fr, fq * 8);
#define PG8_SA(b, h) (((b) * 2 + (h)) * HTB)
#define PG8_SB(b, h) ((4 + (b) * 2 + (h)) * HTB)
#define PG8_STAGE(bufoff, gbase, voff) do { _Pragma("unroll") for (int _i = 0; _i < 2; ++_i) \
    __builtin_amdgcn_global_load_lds((const unsigned*)((const char*)(gbase) + (voff)[_i]), (LAS unsigned*)(lds + (bufoff) + ldsw + _i * 8192), 16, 0, 0); } while (0)
#define PG8_LDA(dst, b, h) do { _Pragma("unroll") for (int m = 0; m < 4; ++m) _Pragma("unroll") for (int k = 0; k < 2; ++k) dst[m][k] = *(const LAS bf16x8*)(lds + PG8_SA(b, h) + aoff + m * 2048 + k * 1024); } while (0)
#define PG8_LDB(dst, b, h) do { _Pragma("unroll") for (int n = 0; n < 2; ++n) _Pragma("unroll") for (int k = 0; k < 2; ++k) dst[n][k] = *(const LAS bf16x8*)(lds + PG8_SB(b, h) + boff + n * 2048 + k * 1024); } while (0)
#define PG8_MMA(ai, bj, At, Bt) do { __builtin_amdgcn_s_setprio(1); _Pragma("unroll") for (int m = 0; m < 4; ++m) _Pragma("unroll") for (int n = 0; n < 2; ++n) _Pragma("unroll") for (int k = 0; k < 2; ++k) \
    acc[ai][bj][m][n] = __builtin_amdgcn_mfma_f32_16x16x32_bf16(Bt[n][k], At[m][k], acc[ai][bj][m][n], 0, 0, 0); __builtin_amdgcn_s_setprio(0); } while (0)
#define PG8_WAIT_V(n) asm volatile("s_waitcnt vmcnt(" #n ")" ::: "memory")
#define PG8_WAIT_L(n) asm volatile("s_waitcnt lgkmcnt(" #n ")" ::: "memory")
#define PG8_BAR __builtin_amdgcn_s_barrier()
#define PG8_SCHED __builtin_amdgcn_sched_barrier(0)
  Unit cur, nxt; int ui = 0;
  if (!S.next(0, cur)) return;
  f32x4 acc[2][2][4][2];
#pragma unroll
  for (int a = 0; a < 2; ++a)
#pragma unroll
    for (int b = 0; b < 2; ++b)
#pragma unroll
      for (int m = 0; m < 4; ++m)
#pragma unroll
        for (int n = 0; n < 2; ++n) acc[a][b][m][n] = (f32x4){0.f, 0.f, 0.f, 0.f};
  bf16x8 At[4][2], B0[2][2], B1[2][2];
  const char* cA = (const char*)g.A + (size_t)cur.pm * tstep; const char* cB = (const char*)g.Bt + (size_t)cur.pn * tstep;
  PG8_STAGE(PG8_SB(0, 0), cB, voffB); PG8_STAGE(PG8_SA(0, 0), cA, voffA); PG8_STAGE(PG8_SB(0, 1), cB + hstep, voffB); PG8_STAGE(PG8_SA(0, 1), cA + hstep, voffA);
  if (wr == 1) PG8_BAR;
  PG8_WAIT_V(4); PG8_BAR;
  PG8_STAGE(PG8_SB(1, 0), cB + kstep, voffB); PG8_STAGE(PG8_SA(1, 0), cA + kstep, voffA); PG8_STAGE(PG8_SB(1, 1), cB + hstep + kstep, voffB);
  PG8_WAIT_V(6); PG8_BAR;
  for (;;) {
    const bool has_next = S.next(ui + 1, nxt);
    const char* nA = has_next ? (const char*)g.A + (size_t)nxt.pm * tstep : cA; const char* nB = has_next ? (const char*)g.Bt + (size_t)nxt.pn * tstep : cB;
#pragma unroll 1
    for (int t = 0; t < nt; t += 2) {
      const bool last = (t == nt - 2);
      const char* a1 = cA + (size_t)(t + 1) * kstep;
      const char* a2 = last ? nA : cA + (size_t)(t + 2) * kstep; const char* b2 = last ? nB : cB + (size_t)(t + 2) * kstep;
      const char* a3 = a2 + kstep; const char* b3 = b2 + kstep;
      PG8_LDB(B0, 0, 0); PG8_SCHED; PG8_LDA(At, 0, 0); PG8_STAGE(PG8_SA(1, 1), a1 + hstep, voffA);
      PG8_WAIT_L(8); PG8_BAR; PG8_WAIT_L(0); PG8_MMA(0, 0, At, B0); PG8_BAR; PG8_SCHED;
      PG8_LDB(B1, 0, 1); PG8_STAGE(PG8_SB(0, 0), b2, voffB);
      PG8_BAR; PG8_WAIT_L(0); PG8_MMA(0, 1, At, B1); PG8_BAR;
      PG8_LDA(At, 0, 1); PG8_STAGE(PG8_SA(0, 0), a2, voffA);
      PG8_BAR; PG8_WAIT_L(0); PG8_MMA(1, 0, At, B0); PG8_BAR; PG8_SCHED;
      PG8_STAGE(PG8_SB(0, 1), b2 + hstep, voffB);
      PG8_WAIT_V(6); PG8_BAR; PG8_MMA(1, 1, At, B1); PG8_BAR;
      PG8_LDB(B0, 1, 0); PG8_SCHED; PG8_LDA(At, 1, 0); PG8_STAGE(PG8_SA(0, 1), a2 + hstep, voffA);
      PG8_WAIT_L(8); PG8_BAR; PG8_WAIT_L(0); PG8_MMA(0, 0, At, B0); PG8_BAR; PG8_SCHED;
      PG8_LDB(B1, 1, 1); PG8_STAGE(PG8_SB(1, 0), b3, voffB);
      PG8_BAR; PG8_WAIT_L(0); PG8_MMA(0, 1, At, B1); PG8_BAR;
      PG8_LDA(At, 1, 1); PG8_STAGE(PG8_SA(1, 0), a3, voffA);
      PG8_BAR; PG8_WAIT_L(0); PG8_MMA(1, 0, At, B0); PG8_BAR; PG8_SCHED;
      PG8_STAGE(PG8_SB(1, 1), b3 + hstep, voffB);
      PG8_WAIT_V(6); PG8_BAR; PG8_MMA(1, 1, At, B1); PG8_BAR;
    }
    E(acc, cur, wr, wc, fr, fq);
    if (!has_next) break;
#pragma unroll
    for (int a = 0; a < 2; ++a)
#pragma unroll
      for (int b = 0; b < 2; ++b)
#pragma unroll
        for (int m = 0; m < 4; ++m)
#pragma unroll
          for (int n = 0; n < 2; ++n) acc[a][b][m][n] = (f32x4){0.f, 0.f, 0.f, 0.f};
    cur = nxt; cA = nA; cB = nB; ++ui;
  }
  PG8_WAIT_V(0);
  if (wr == 0) PG8_BAR;
  PG8_BAR;
#undef PG8_SA
#undef PG8_SB
#undef PG8_STAGE
#undef PG8_LDA
#undef PG8_LDB
#undef PG8_MMA
#undef PG8_WAIT_V
#undef PG8_WAIT_L
#undef PG8_BAR
#undef PG8_SCHED
}
}

enum { EPI_ABIN = 0, EPI_UQ = 1, EPI_UKV = 2, EPI_CIN = 3, EPI_RESID = 4, EPI_RELU2 = 5 };

template <int EPI> struct Epi {
  static constexpr bool PERM = (EPI == EPI_RELU2 || EPI == EPI_RESID || EPI == EPI_CIN || EPI == EPI_UKV), AFTER_DRAIN = false;
  char* big; const float* rsrc; float* rdst; const float* tcos; const float* tsin;
  const LAS float* rinv_tab;
  u16* xr; float* ss_out;
  mutable int round;
  DI void operator()(const f32x4 (&acc)[2][2][4][2], const pg8::Unit& u, int wr, int wc, int fr_, int fq_) const {
    const int t_ = get_tid();
    const int fr = t_ & 15, fq = (t_ >> 4) & 3;
    const int slot = round; round = round + 1;
#pragma unroll
    for (int ai = 0; ai < 2; ++ai)
#pragma unroll
      for (int m = 0; m < 4; ++m) {
        const int rl = ai * 128 + wr * 64 + m * 16 + fr;
        const int token = u.pm * 256 + rl;
        float rinv = 1.f;
        if (EPI != EPI_RESID) rinv = rinv_tab[slot * 256 + rl];
        float ssq = 0.f;
#pragma unroll
        for (int bj = 0; bj < 2; ++bj)
#pragma unroll
          for (int n = 0; n < 2; ++n) {
            const int fb = u.pn * 256 + bj * 128 + wc * 32 + n * 16;
            const int f = fb + 4 * fq;
            const f32x4 v = acc[ai][bj][m][n];
            if (EPI == EPI_ABIN) {
              if (fb < 384) st_bf4((u16*)(big + E_CQ) + (size_t)token * 384 + f, v, rinv);
              else if (fb < 640) st_bf4((u16*)(big + E_CKV) + (size_t)token * 256 + (f - 384), v, rinv);
              else if (fb < 672) {
                if (n == 0) {
                  const f32x4 b = acc[ai][bj][m][1];
                  const int pos = token & (S_ - 1);
                  const f32x4 c4 = *(const f32x4*)(tcos + pos * 16 + 4 * fq);
                  const f32x4 s4 = *(const f32x4*)(tsin + pos * 16 + 4 * fq);
                  const f32x4 lo = v * c4 - b * s4, hi = b * c4 + v * s4;
                  u16* kp = (u16*)(big + E_KPE) + (size_t)token * 32 + 4 * fq;
                  st_bf4(kp, lo, rinv); st_bf4(kp + 16, hi, rinv);
                }
              }
              else if (fb < 1184) st_bf4((u16*)(big + E_QNA) + (size_t)token * 512 + (f - 672), v, rinv * (0.125f * LOG2E));
              else if (fb < 1696) st_bf4((u16*)(big + E_KNA) + (size_t)token * 512 + (f - 1184), v, rinv);
              else if (fb < 2208) {
                const int fv = f - 1696; const int hd = fv >> 6, dv = fv & 63;
                st_bf4((u16*)(big + E_VNAT) + (size_t)token * 512 + hd * 64 + dv, v, rinv);
              }
            } else if (EPI == EPI_UQ) {
              const float sc = rinv * (0.10206207261596575f * LOG2E);
              const int hd = fb / 96; const int within = fb - hd * 96;
              if (within < 64) st_bf4((u16*)(big + E_QMLA) + (size_t)token * 768 + f, v, sc);
              else if (within == 64 && n == 0) {
                const f32x4 b = acc[ai][bj][m][1];
                const int pos = token & (S_ - 1);
                const f32x4 c4 = *(const f32x4*)(tcos + pos * 16 + 4 * fq);
                const f32x4 s4 = *(const f32x4*)(tsin + pos * 16 + 4 * fq);
                const f32x4 lo = v * c4 - b * s4, hi = b * c4 + v * s4;
                u16* qp = (u16*)(big + E_QMLA) + (size_t)token * 768 + f;
                st_bf4(qp, lo, sc); st_bf4(qp + 16, hi, sc);
              }
            } else if (EPI == EPI_UKV) {
              if (n == 0) {
                const int gb = u.pn * 256 + bj * 128 + wc * 32;
                const int hd = gb >> 7, within = (gb & 127) + 8 * fq;
                const f32x4 v1 = acc[ai][bj][m][1];
                if (within < 64) st_bf8((u16*)(big + E_KNOPE) + (size_t)token * 512 + hd * 64 + within, v, v1, rinv);
                else st_bf8((u16*)(big + E_VMLAT) + (size_t)token * 512 + hd * 64 + (within - 64), v, v1, rinv);
              }
            } else if (EPI == EPI_CIN) {
              if (n == 0) {
                const int gb = u.pn * 256 + bj * 128 + wc * 32;
                const int f8 = gb + 8 * fq;
                const f32x4 v1 = acc[ai][bj][m][1];
                if (gb < 1024) st_bf8((u16*)(big + O_QD) + (size_t)token * 1024 + f8, v, v1, rinv * (0.125f * LOG2E));
                else if (gb < 2048) st_bf8((u16*)(big + O_KD) + (size_t)token * 1024 + (f8 - 1024), v, v1, rinv);
                else st_bf8((u16*)(big + O_VDT) + (size_t)token * 1024 + (f8 - 2048), v, v1, rinv);
              }
            } else if (EPI == EPI_RESID) {
              if (n == 0) {
                const int f8 = u.pn * 256 + bj * 128 + wc * 32 + 8 * fq;
                const f32x4 v1 = acc[ai][bj][m][1];
                f32x4 r0, r1;
                if (rsrc) {
                  r0 = *(const f32x4*)(rsrc + (size_t)token * 1024 + f8); r1 = *(const f32x4*)(rsrc + (size_t)token * 1024 + f8 + 4);
                } else {
                  const u32x4 xu = *(const u32x4*)(xr + (size_t)token * 1024 + f8);
                  r0 = (f32x4){bf2f(xu.x & 0xffffu), bf2f(xu.x >> 16), bf2f(xu.y & 0xffffu), bf2f(xu.y >> 16)};
                  r1 = (f32x4){bf2f(xu.z & 0xffffu), bf2f(xu.z >> 16), bf2f(xu.w & 0xffffu), bf2f(xu.w >> 16)};
                }
                r0 += v; r1 += v1;
                st_bf8(xr + (size_t)token * 1024 + f8, r0, r1, 1.f);
                ssq += r0[0] * r0[0] + r0[1] * r0[1] + r0[2] * r0[2] + r0[3] * r0[3] + r1[0] * r1[0] + r1[1] * r1[1] + r1[2] * r1[2] + r1[3] * r1[3];
              }
            } else {
              if (n == 0) {
                const f32x4 v1 = acc[ai][bj][m][1];
                u32x4 o4;
                { const float t0 = fmaxf(v[0], 0.f) * rinv, t1 = fmaxf(v[1], 0.f) * rinv, t2 = fmaxf(v[2], 0.f) * rinv, t3 = fmaxf(v[3], 0.f) * rinv;
                  o4.x = pack2(t0 * t0, t1 * t1); o4.y = pack2(t2 * t2, t3 * t3); }
                { const float t0 = fmaxf(v1[0], 0.f) * rinv, t1 = fmaxf(v1[1], 0.f) * rinv, t2 = fmaxf(v1[2], 0.f) * rinv, t3 = fmaxf(v1[3], 0.f) * rinv;
                  o4.z = pack2(t0 * t0, t1 * t1); o4.w = pack2(t2 * t2, t3 * t3); }
                u32x4* hp = (u32x4*)((u16*)big + (size_t)token * 4096 + u.pn * 256 + bj * 128 + wc * 32 + 8 * fq);
                if (slot < 4) __builtin_nontemporal_store(o4, hp); else *hp = o4;
              }
            }
          }
        if (EPI == EPI_RESID) {
          ssq += shx(ssq, 16, t_ & 63);
          ssq += shx(ssq, 32, t_ & 63);
          if (fq == 0) ss_out[(size_t)token * 16 + u.pn * 4 + wc] = ssq;
        }
      }
  }
};

DI void rinv_prepass(const u16* __restrict__ A, int K, const pg8::StaticOrder& S, LAS float* tab) {
  const int tid = get_tid();
  const int row = tid >> 1, half = tid & 1;
  pg8::Unit u;
  for (int i = 0; i < 4 && S.next(i, u); ++i) {
    const u16* pr = A + (size_t)(u.pm * 256 + row) * K + half * (K >> 1);
    float ss = 0.f;
    for (int c = 0; c < (K >> 1); c += 8) {
      u32x4 w = *(const u32x4*)(pr + c);
      float a;
      a = bf2f(w.x & 0xffffu); ss += a * a; a = bf2f(w.x >> 16); ss += a * a;
      a = bf2f(w.y & 0xffffu); ss += a * a; a = bf2f(w.y >> 16); ss += a * a;
      a = bf2f(w.z & 0xffffu); ss += a * a; a = bf2f(w.z >> 16); ss += a * a;
      a = bf2f(w.w & 0xffffu); ss += a * a; a = bf2f(w.w >> 16); ss += a * a;
    }
    ss += shx(ss, 1, tid & 63);
    if (!half) tab[i * 256 + row] = rsqrtf(ss / (float)K + EPS);
  }
  __syncthreads();
}

DI void norm_prepass(const float* __restrict__ ss, const pg8::StaticOrder& S, LAS float* tab) {
  const int tid = get_tid();
  const int row = tid >> 1, half = tid & 1;
  pg8::Unit u;
  for (int i = 0; i < 8 && S.next(i, u); ++i) {
    const f32x4* sp = (const f32x4*)(ss + (size_t)(u.pm * 256 + row) * 16 + half * 8);
    const f32x4 a = sp[0], b = sp[1];
    float t = a[0]; t += a[1]; t += a[2]; t += a[3]; t += b[0]; t += b[1]; t += b[2]; t += b[3];
    const float o = shx(t, 1, tid & 63);
    const float tot = half ? (o + t) : (t + o);
    if (!half) tab[i * 256 + row] = rsqrtf(tot * (1.f / 1024.f) + EPS);
  }
  __syncthreads();
}

template <int EPI>
DI void run_gemm(LAS unsigned char* lds, const u16* A, const u16* Bt, int N, int K, const Params& q, const float* rsrc,
                 const float* ss_in, float* ss_out) {
  pg8::Gemm g; g.A = A; g.Bt = Bt; g.M = T_; g.N = N; g.K = K;
  pg8::StaticOrder S; S.init(T_, N, gridDim.x, blockIdx.x);
  if (EPI == EPI_RESID && K == 4096) S.rev = 1;
  Epi<EPI> E;
  E.big = q.ws + B_BIG; E.rsrc = rsrc; E.rdst = q.xres;
  E.tcos = (const float*)(q.ws + TB_COS); E.tsin = (const float*)(q.ws + TB_SIN);
  E.rinv_tab = (const LAS float*)(lds + SM_RINVTAB); E.round = 0;
  E.xr = (u16*)(q.ws + B_XR); E.ss_out = ss_out;
  if (EPI == EPI_UQ || EPI == EPI_UKV) rinv_prepass(A, K, S, (LAS float*)(lds + SM_RINVTAB));
  if (EPI == EPI_ABIN || EPI == EPI_CIN || EPI == EPI_RELU2) norm_prepass(ss_in, S, (LAS float*)(lds + SM_RINVTAB));
  pg8::gemm_phase(lds, g, S, E);
}

DI bool softmax_tile(f32x16& s0, f32x16& s1, float& m, float& l, float& alpha, bf16x8* pf, int lane, bool first, bool check) {
  if (first) {
    float mx = fmaxf(s0[0], s1[0]);
#pragma unroll
    for (int i = 1; i < 16; ++i) mx = fmaxf(mx, fmaxf(s0[i], s1[i]));
    mx = fmaxf(mx, shx(mx, 32, lane));
    m += mx;
#pragma unroll
    for (int i = 0; i < 16; ++i) { s0[i] -= mx; s1[i] -= mx; }
  }
  float sum = 0.f;
#pragma unroll
  for (int i = 0; i < 16; ++i) { s0[i] = __builtin_amdgcn_exp2f(s0[i]); sum += s0[i]; }
#pragma unroll
  for (int i = 0; i < 16; ++i) { s1[i] = __builtin_amdgcn_exp2f(s1[i]); sum += s1[i]; }
  l += sum;
  pf[0] = pack8(s0, 0); pf[1] = pack8(s0, 8); pf[2] = pack8(s1, 0); pf[3] = pack8(s1, 8);
  alpha = 1.f;
  if (!check) return false;
  const float rsum = sum + shx(sum, 32, lane);
  const bool trig = rsum > 65536.f;
  const bool resc = (__builtin_amdgcn_ballot_w64(trig) != 0ull);
  alpha = 1.f;
  if (resc) {
    const float d = trig ? (float)(__builtin_amdgcn_frexp_expf(rsum) - 7) : 0.f;
    alpha = __builtin_amdgcn_exp2f(-d);
    m += d; l *= alpha;
  }
  return resc;
}
DI int tr_base(int lane, int RS) {
  const int hh = lane >> 5, g1 = (lane >> 4) & 1, q = (lane >> 2) & 3, pp = lane & 3;
  return (4 * hh + q) * RS + (16 * g1 + 4 * pp) * 2;
}
DI bf16x8 ld_vfrag_tr(const char* vs, int vbase, int RS, int koff, int coff) {
  const char* a = vs + vbase + koff * RS + coff * 2;
  const s16x4 lo = __builtin_amdgcn_ds_read_tr16_b64_v4i16((LAS s16x4*)a);
  const s16x4 hi = __builtin_amdgcn_ds_read_tr16_b64_v4i16((LAS s16x4*)(a + 8 * RS));
  return __builtin_shufflevector(lo, hi, 0, 1, 2, 3, 4, 5, 6, 7);
}
DI bf16x8 ld_vfrag_s(const char* vs, int stride, int dvrow, int keyoff, int s, int hh) {
  const char* a = vs + dvrow * stride + (keyoff + 16 * s + 4 * hh) * 2;
  s16x4 lo = *(const s16x4*)a;
  s16x4 hi = *(const s16x4*)(a + 16);
  return __builtin_shufflevector(lo, hi, 0, 1, 2, 3, 4, 5, 6, 7);
}
DI void st_vt_s(char* vs, int stride, int dvrow, int part, u32x4 v) {
  char* a = vs + dvrow * stride + part * 16;
  *(u32x2*)a = (u32x2){v.x, v.y};
  *(u32x2*)(a + 8) = (u32x2){v.z, v.w};
}
DI bf16x8 ld_vfrag(const char* vs, int dvrow, int s, int hh) {
  const char* a = vs + dvrow * 136 + (16 * s + 4 * hh) * 2;
  s16x4 lo = *(const s16x4*)a;
  s16x4 hi = *(const s16x4*)(a + 16);
  return __builtin_shufflevector(lo, hi, 0, 1, 2, 3, 4, 5, 6, 7);
}
DI void st_vt(char* vs, int dvrow, int part, u32x4 v) {
  char* a = vs + dvrow * 136 + part * 16;
  *(u32x2*)a = (u32x2){v.x, v.y};
  *(u32x2*)(a + 8) = (u32x2){v.z, v.w};
}
DI void scale16(f32x16& o, float a) {
#pragma unroll
  for (int i = 0; i < 16; ++i) o[i] *= a;
}

DI void attn_mla_unit(const Params& p, int b, int h, int qb, char* smem, bool pre, int nh, bool has_next) {
  const int tid = get_tid(), lane = tid & 63, w = tid >> 6, r32 = lane & 31, hh = lane >> 5;
  char* big = p.ws + B_BIG;
  const u16* qmla = (const u16*)(big + E_QMLA);
  const u16* knope = (const u16*)(big + E_KNOPE);
  const u16* kpe = (const u16*)(big + E_KPE);
  const u16* vT = (const u16*)(big + E_VMLAT);
  u16* o = (u16*)(p.ws + B_H);
  constexpr int KR = 208, VR = 192;
  constexpr int STG = 128 * KR + 128 * VR;
  const int vbase = tr_base(lane, VR);
  const int qrow = b * S_ + qb * 256 + w * 32 + r32;
  bf16x8 qf[6];
#pragma unroll
  for (int s = 0; s < 6; ++s) qf[s] = *(const bf16x8*)(qmla + (size_t)qrow * 768 + h * 96 + s * 16 + hh * 8);
  f32x16 O0, O1;
#pragma unroll
  for (int i = 0; i < 16; ++i) { O0[i] = 0.f; O1[i] = 0.f; }
  float m = 0.f, l = 0.f;
  const int krow = tid >> 3, kpart = tid & 7;
  const int prow = tid >> 2, ppart = tid & 3;
  const int vrow = tid >> 3, vpart = tid & 7;
  const u16* gk = knope + (size_t)(b * S_ + krow) * 512 + h * 64 + kpart * 8;
  const u16* gp = kpe + (size_t)(b * S_ + prow) * 32 + ppart * 8;
  const u16* gv = vT + (size_t)(b * S_ + vrow) * 512 + h * 64 + vpart * 8;
  u32x4 rk[2], rp, rv[2];
  if (!pre) {
#pragma unroll
    for (int i = 0; i < 2; ++i) { rk[i] = *(const u32x4*)(gk + (size_t)i * 64 * 512); rv[i] = *(const u32x4*)(gv + (size_t)i * 64 * 512); }
    rp = *(const u32x4*)gp;
  }
  auto put_stage = [&](char* kb) {
    char* vb = kb + 128 * KR;
#pragma unroll
    for (int i = 0; i < 2; ++i) {
      *(u32x4*)(kb + (krow + 64 * i) * KR + kpart * 16) = rk[i];
      *(u32x4*)(vb + (vrow + 64 * i) * VR + vpart * 16) = rv[i];
    }
    *(u32x4*)(kb + prow * KR + 128 + ppart * 16) = rp;
  };
  auto get_stage = [&](int st) {
    const int k0 = st * 128;
#pragma unroll
    for (int i = 0; i < 2; ++i) { rk[i] = *(const u32x4*)(gk + (size_t)(k0 + i * 64) * 512); rv[i] = *(const u32x4*)(gv + (size_t)(k0 + i * 64) * 512); }
    rp = *(const u32x4*)(gp + (size_t)k0 * 32);
  };
  __syncthreads();
  if (!pre) put_stage(smem);
  __syncthreads();
  get_stage(1);
  for (int kt = 0; kt < 32; ++kt) {
    const char* ks = smem + (kt & 1) * STG; const char* vs = ks + 128 * KR;
#pragma unroll
    for (int sub = 0; sub < 2; ++sub) {
      f32x16 s0, s1;
#pragma unroll
      for (int i = 0; i < 16; ++i) { s0[i] = -m; s1[i] = -m; }
      {
        bf16x8 kf[12];
#pragma unroll
        for (int s = 0; s < 6; ++s) {
          kf[2 * s] = *(const bf16x8*)(ks + (sub * 64 + r32) * KR + (s * 16 + hh * 8) * 2);
          kf[2 * s + 1] = *(const bf16x8*)(ks + (sub * 64 + 32 + r32) * KR + (s * 16 + hh * 8) * 2);
        }
        __builtin_amdgcn_sched_barrier(0); __builtin_amdgcn_s_setprio(1);
#pragma unroll
        for (int s = 0; s < 6; ++s) { s0 = mfma32(kf[2 * s], qf[s], s0); s1 = mfma32(kf[2 * s + 1], qf[s], s1); }
      __builtin_amdgcn_s_setprio(0);
}
      float alpha; bf16x8 pf[4];
      const bool resc = softmax_tile(s0, s1, m, l, alpha, pf, lane, (kt == 0) && (sub == 0), sub == 0);
      {
        bf16x8 vf[8];
#pragma unroll
        for (int s = 0; s < 4; ++s) { vf[2 * s] = ld_vfrag_tr(vs, vbase, VR, sub * 64 + 16 * s, 0); vf[2 * s + 1] = ld_vfrag_tr(vs, vbase, VR, sub * 64 + 16 * s, 32); }
        __builtin_amdgcn_sched_barrier(0); __builtin_amdgcn_s_setprio(1);
#pragma unroll
        for (int s = 0; s < 4; ++s) { O0 = mfma32(vf[2 * s], pf[s], O0); O1 = mfma32(vf[2 * s + 1], pf[s], O1); }
      __builtin_amdgcn_s_setprio(0);
}
      if (resc) { scale16(O0, alpha); scale16(O1, alpha); }
    }
    if (kt + 1 < 32) put_stage(smem + ((kt + 1) & 1) * STG);
    else if (has_next) put_stage(smem);
    __syncthreads();
    if (kt + 2 < 32) get_stage(kt + 2);
    else if (kt == 30 && has_next) { gk += (nh - h) * 64; gv += (nh - h) * 64; get_stage(0); }
  }
  const float lt = l + shx(l, 32, lane);
  const float inv = 1.f / lt;
  u16* op = o + (size_t)qrow * 1024 + h * 64 + 4 * hh;
#pragma unroll
  for (int i4 = 0; i4 < 4; ++i4) {
    st_bf4(op + 8 * i4, (f32x4){O0[4 * i4], O0[4 * i4 + 1], O0[4 * i4 + 2], O0[4 * i4 + 3]}, inv);
    st_bf4(op + 32 + 8 * i4, (f32x4){O1[4 * i4], O1[4 * i4 + 1], O1[4 * i4 + 2], O1[4 * i4 + 3]}, inv);
  }
}

DI void attn_na_unit(const Params& p, int li, int b, int r, int hp, char* smem) {
  const int tid = get_tid() & 255, lane = tid & 63, w = tid >> 6, r32 = lane & 31, hh = lane >> 5;
  char* big = p.ws + B_BIG;
  const u16* qna = (const u16*)(big + E_QNA);
  const u16* kna = (const u16*)(big + E_KNA);
  const u16* vT = (const u16*)(big + E_VNAT);
  u16* o = (u16*)(p.ws + B_H);
  char* ks = smem; char* vs = smem + SM_ATT_V; float* tab = (float*)(smem + SM_ATT_TAB);
  constexpr int KR = 272, VR = 320;
  const int vbase = tr_base(lane, VR);
  const int qbk = w & 1, hs = w >> 1, head = 2 * hp + hs;
  const int wq = 32 * qbk + r32;
  const int qrow = b * S_ + r * 64 + wq;
  int cs = wq - 8; cs = cs < 0 ? 0 : (cs > 48 ? 48 : cs);
  int rs = r - 4; rs = rs < 0 ? 0 : (rs > 56 ? 56 : rs);
  __syncthreads();
  for (int idx = tid; idx < 2 * 465; idx += 256) {
    int hsel = idx >= 465 ? 1 : 0; int rem = idx - hsel * 465;
    tab[idx] = p.ab_rpb[((size_t)(li * 8 + 2 * hp + hsel)) * 465 + rem] * LOG2E;
  }
  bf16x8 qf[4];
#pragma unroll
  for (int s = 0; s < 4; ++s) qf[s] = *(const bf16x8*)(qna + (size_t)qrow * 512 + head * 64 + s * 16 + hh * 8);
  f32x16 O0, O1;
#pragma unroll
  for (int i = 0; i < 16; ++i) { O0[i] = 0.f; O1[i] = 0.f; }
  float m = 0.f, l = 0.f;
  const int krow = tid >> 4, kpart = tid & 15;
  const u16* gk = kna + (size_t)(b * S_ + rs * 64 + krow) * 512 + hp * 128 + kpart * 8;
  const u16* gv = vT + (size_t)(b * S_ + rs * 64 + krow) * 512 + hp * 128 + kpart * 8;
  u32x4 rk[4], rv[4];
#pragma unroll
  for (int i = 0; i < 4; ++i) { rk[i] = *(const u32x4*)(gk + (size_t)i * 16 * 512); rv[i] = *(const u32x4*)(gv + (size_t)i * 16 * 512); }
  for (int kt = 0; kt < 8; ++kt) {
    __syncthreads();
#pragma unroll
    for (int i = 0; i < 4; ++i) {
      *(u32x4*)(ks + (krow + 16 * i) * KR + kpart * 16) = rk[i];
      *(u32x4*)(vs + (krow + 16 * i) * VR + kpart * 16) = rv[i];
    }
    __syncthreads();
    if (kt + 1 < 8) {
      const int k0 = (kt + 1) * 64;
#pragma unroll
      for (int i = 0; i < 4; ++i) { rk[i] = *(const u32x4*)(gk + (size_t)(k0 + i * 16) * 512); rv[i] = *(const u32x4*)(gv + (size_t)(k0 + i * 16) * 512); }
    }
    f32x16 s0, s1;
#pragma unroll
    for (int i = 0; i < 16; ++i) { s0[i] = -m; s1[i] = -m; }
    {
      bf16x8 kf[8];
#pragma unroll
      for (int s = 0; s < 4; ++s) {
        kf[2 * s] = *(const bf16x8*)(ks + r32 * KR + (hs * 64 + s * 16 + hh * 8) * 2);
        kf[2 * s + 1] = *(const bf16x8*)(ks + (32 + r32) * KR + (hs * 64 + s * 16 + hh * 8) * 2);
      }
      __builtin_amdgcn_sched_barrier(0); __builtin_amdgcn_s_setprio(1);
#pragma unroll
      for (int s = 0; s < 4; ++s) { s0 = mfma32(kf[2 * s], qf[s], s0); s1 = mfma32(kf[2 * s + 1], qf[s], s1); }
    __builtin_amdgcn_s_setprio(0);
}
    const int drow = rs + kt - r + 7;
    const float* trow = tab + hs * 465 + drow * 31;
#pragma unroll
    for (int i = 0; i < 16; ++i) {
      const int kc0 = (i & 3) + 8 * (i >> 2) + 4 * hh;
      const int kc1 = kc0 + 32;
      const bool v0 = (unsigned)(kc0 - cs) < 16u;
      const bool v1 = (unsigned)(kc1 - cs) < 16u;
      const int d0 = v0 ? (kc0 - wq + 15) : 0;
      const int d1 = v1 ? (kc1 - wq + 15) : 0;
      const float b0 = trow[d0], b1 = trow[d1];
      s0[i] = v0 ? s0[i] + b0 : -1e30f;
      s1[i] = v1 ? s1[i] + b1 : -1e30f;
    }
    float alpha; bf16x8 pf[4];
    const bool resc = softmax_tile(s0, s1, m, l, alpha, pf, lane, kt == 0, true);
    {
      bf16x8 vf[8];
#pragma unroll
      for (int s = 0; s < 4; ++s) { vf[2 * s] = ld_vfrag_tr(vs, vbase, VR, 16 * s, hs * 64); vf[2 * s + 1] = ld_vfrag_tr(vs, vbase, VR, 16 * s, hs * 64 + 32); }
      __builtin_amdgcn_sched_barrier(0); __builtin_amdgcn_s_setprio(1);
#pragma unroll
      for (int s = 0; s < 4; ++s) { O0 = mfma32(vf[2 * s], pf[s], O0); O1 = mfma32(vf[2 * s + 1], pf[s], O1); }
    __builtin_amdgcn_s_setprio(0);
}
    if (resc) { scale16(O0, alpha); scale16(O1, alpha); }
  }
  const float lt = l + shx(l, 32, lane);
  const float inv = 1.f / lt;
  u16* op = o + (size_t)qrow * 1024 + 512 + head * 64 + 4 * hh;
#pragma unroll
  for (int i4 = 0; i4 < 4; ++i4) {
    st_bf4(op + 8 * i4, (f32x4){O0[4 * i4], O0[4 * i4 + 1], O0[4 * i4 + 2], O0[4 * i4 + 3]}, inv);
    st_bf4(op + 32 + 8 * i4, (f32x4){O1[4 * i4], O1[4 * i4 + 1], O1[4 * i4 + 2], O1[4 * i4 + 3]}, inv);
  }
}

DI void attn_diff_unit(const Params& p, int li, int b, int h, int qb, char* smem, bool pre, int nh, bool has_next) {
  const int tid = get_tid(), lane = tid & 63, w = tid >> 6, r32 = lane & 31, hh = lane >> 5;
  char* big = p.ws + B_BIG;
  const u16* qd = (const u16*)(big + O_QD);
  const u16* kd = (const u16*)(big + O_KD);
  const u16* vT = (const u16*)(big + O_VDT);
  u16* o = (u16*)(p.ws + B_H);
  constexpr int KR = 272, VR = 320;
  constexpr int STG = 128 * KR + 128 * VR;
  const int vbase = tr_base(lane, VR);
  float* tab = (float*)(smem + 2 * STG);
  const int rg = w & 3, map = w >> 2;
  const int qpos = qb * 128 + rg * 32 + r32;
  const int qrow = b * S_ + qpos;
  __syncthreads();
  const float* t5t = (const float*)(p.ws + TB_T5) + h * 512;
  if (tid < 512) tab[tid] = t5t[tid];
  const float cL = t5t[0], cR = t5t[510];
  bf16x8 qf[4];
#pragma unroll
  for (int s = 0; s < 4; ++s) qf[s] = *(const bf16x8*)(qd + (size_t)qrow * 1024 + h * 128 + map * 64 + s * 16 + hh * 8);
  f32x16 O[4];
#pragma unroll
  for (int j = 0; j < 4; ++j)
#pragma unroll
    for (int i = 0; i < 16; ++i) O[j][i] = 0.f;
  float m = 0.f, l = 0.f;
  const int krow = tid >> 4, kpart = tid & 15;
  const u16* gk = kd + (size_t)(b * S_ + krow) * 1024 + h * 128 + kpart * 8;
  const u16* gv = vT + (size_t)(b * S_ + krow) * 1024 + h * 128 + kpart * 8;
  u32x4 rk[4], rv[4];
  if (!pre) {
#pragma unroll
    for (int i = 0; i < 4; ++i) { rk[i] = *(const u32x4*)(gk + (size_t)i * 32 * 1024); rv[i] = *(const u32x4*)(gv + (size_t)i * 32 * 1024); }
  }
  auto put_stage = [&](char* kb) {
    char* vb = kb + 128 * KR;
#pragma unroll
    for (int i = 0; i < 4; ++i) {
      *(u32x4*)(kb + (krow + 32 * i) * KR + kpart * 16) = rk[i];
      *(u32x4*)(vb + (krow + 32 * i) * VR + kpart * 16) = rv[i];
    }
  };
  auto get_stage = [&](int st) {
    const int k0 = st * 128;
#pragma unroll
    for (int i = 0; i < 4; ++i) { rk[i] = *(const u32x4*)(gk + (size_t)(k0 + i * 32) * 1024); rv[i] = *(const u32x4*)(gv + (size_t)(k0 + i * 32) * 1024); }
  };
  if (!pre) put_stage(smem);
  __syncthreads();
  get_stage(1);
  for (int kt = 0; kt < 32; ++kt) {
    const char* ks = smem + (kt & 1) * STG; const char* vs = ks + 128 * KR;
#pragma unroll
    for (int sub = 0; sub < 2; ++sub) {
      const int kbase = kt * 128 + sub * 64;
      const int relmin = kbase - (qb * 128 + 127), relmax = kbase + 63 - qb * 128;
      const float cb = (relmin >= 128) ? cR : ((relmax <= -128) ? cL : 0.f);
      f32x16 s0, s1;
#pragma unroll
      for (int i = 0; i < 16; ++i) { s0[i] = cb - m; s1[i] = cb - m; }
      {
        bf16x8 kf[8];
#pragma unroll
        for (int s = 0; s < 4; ++s) {
          kf[2 * s] = *(const bf16x8*)(ks + (sub * 64 + r32) * KR + (map * 64 + s * 16 + hh * 8) * 2);
          kf[2 * s + 1] = *(const bf16x8*)(ks + (sub * 64 + 32 + r32) * KR + (map * 64 + s * 16 + hh * 8) * 2);
        }
        __builtin_amdgcn_sched_barrier(0); __builtin_amdgcn_s_setprio(1);
#pragma unroll
        for (int s = 0; s < 4; ++s) { s0 = mfma32(kf[2 * s], qf[s], s0); s1 = mfma32(kf[2 * s + 1], qf[s], s1); }
      __builtin_amdgcn_s_setprio(0);
}
      if (relmin < 128 && relmax > -128) {
        const int base = kbase - qpos + 255 + 4 * hh;
#pragma unroll
        for (int i = 0; i < 16; ++i) {
          int i0 = base + (i & 3) + 8 * (i >> 2);
          int i1 = i0 + 32;
          i0 = i0 < 0 ? 0 : (i0 > 510 ? 510 : i0);
          i1 = i1 < 0 ? 0 : (i1 > 510 ? 510 : i1);
          s0[i] += tab[i0]; s1[i] += tab[i1];
        }
      }
      float alpha; bf16x8 pf[4];
      const bool resc = softmax_tile(s0, s1, m, l, alpha, pf, lane, (kt == 0) && (sub == 0), sub == 0);
      {
        bf16x8 vf[2][4];
#pragma unroll
        for (int j = 0; j < 4; ++j) vf[0][j] = ld_vfrag_tr(vs, vbase, VR, sub * 64, j * 32);
#pragma unroll
        for (int s = 0; s < 4; ++s) {
          if (s < 3) {
#pragma unroll
            for (int j = 0; j < 4; ++j) vf[(s + 1) & 1][j] = ld_vfrag_tr(vs, vbase, VR, sub * 64 + 16 * (s + 1), j * 32);
          }
          __builtin_amdgcn_sched_barrier(0); __builtin_amdgcn_s_setprio(1);
#pragma unroll
          for (int j = 0; j < 4; ++j) O[j] = mfma32(vf[s & 1][j], pf[s], O[j]);
        __builtin_amdgcn_s_setprio(0);
}
      }
      if (resc) {
#pragma unroll
        for (int j = 0; j < 4; ++j) scale16(O[j], alpha);
      }
    }
    if (kt + 1 < 32) put_stage(smem + ((kt + 1) & 1) * STG);
    else if (has_next) put_stage(smem);
    __syncthreads();
    if (kt + 2 < 32) get_stage(kt + 2);
    else if (kt == 30 && has_next) { gk += (nh - h) * 128; gv += (nh - h) * 128; get_stage(0); }
  }
  const float lt = l + shx(l, 32, lane);
  const float inv = 1.f / lt;
  float* xch = (float*)(smem + STG);
  if (map == 1) {
#pragma unroll
    for (int j = 0; j < 4; ++j)
#pragma unroll
      for (int i = 0; i < 16; ++i) xch[(rg * 64 + j * 16 + i) * 64 + lane] = O[j][i] * inv;
  }
  __syncthreads();
  if (map == 0) {
    const float lam = ((const float*)(p.ws + TB_LAM))[li];
    const int layer = 2 * li + 1;
    const float linit = 0.8f - 0.6f * expf(-0.3f * (float)layer);
    float ss = 0.f;
#pragma unroll
    for (int j = 0; j < 4; ++j)
#pragma unroll
      for (int i = 0; i < 16; ++i) {
        float v = O[j][i] * inv - lam * xch[(rg * 64 + j * 16 + i) * 64 + lane];
        O[j][i] = v; ss += v * v;
      }
    ss += shx(ss, 32, lane);
    const float rinv = rsqrtf(ss * (1.f / 128.f) + EPS) * (1.f - linit);
    const float* sub = p.c_subln + li * 128;
    u16* op = o + (size_t)qrow * 1024 + h * 128 + 4 * hh;
#pragma unroll
    for (int j = 0; j < 4; ++j)
#pragma unroll
      for (int i4 = 0; i4 < 4; ++i4) {
        const int dv = j * 32 + 8 * i4 + 4 * hh;
        const f32x4 g4 = *(const f32x4*)(sub + dv);
        f32x4 v = {O[j][4 * i4] * g4[0], O[j][4 * i4 + 1] * g4[1], O[j][4 * i4 + 2] * g4[2], O[j][4 * i4 + 3] * g4[3]};
        st_bf4(op + j * 32 + 8 * i4, v, rinv);
      }
  }
}

#define XB_TMO      128
#define XB_XCNT(j)  (256  + 64 * (j))
#define XB_XSUB(j)  (1280 + 64 * (j))
#define XB_XGEN(j)  (2304 + 64 * (j))
#define XB_TOP      3328
#define XB_TOPGEN   3392
#define XCD_BAR_WORDS 3456
#define XB_SPIN_CAP (1u << 18)
DI unsigned xb_ld(unsigned* p)              { return __hip_atomic_load(p, __ATOMIC_RELAXED, __HIP_MEMORY_SCOPE_AGENT); }
DI unsigned xb_add(unsigned* p, unsigned v) { return __hip_atomic_fetch_add(p, v, __ATOMIC_RELAXED, __HIP_MEMORY_SCOPE_AGENT); }
DI unsigned xb_xcc_id() { return (unsigned)__builtin_amdgcn_s_getreg((3 << 11) | 20) & 0xFu; }
#define XB_SPIN(cond, bar) do { unsigned _sp = 0; while (cond) { __builtin_amdgcn_s_sleep(1); \
    if ((++_sp & 255u) == 0u) { if (xb_ld(&(bar)[XB_TMO])) break; if (_sp > XB_SPIN_CAP) { atomicAdd(&(bar)[XB_TMO], 1u); break; } } } } while (0)
struct XcdBarrier { unsigned* bar; unsigned x; volatile LAS unsigned* st; };
DI XcdBarrier xcd_barrier_post(unsigned* bar, volatile LAS unsigned* st) {
  XcdBarrier b; b.bar = bar; b.x = xb_xcc_id(); b.st = st;
  if (threadIdx.x == 0) (void)xb_add(&bar[XB_XCNT(b.x)], 1u);
  return b;
}
DI void xcd_barrier_complete(unsigned* bar, unsigned x, unsigned& nloc, unsigned& nx) {
  const unsigned G = gridDim.x * gridDim.y * gridDim.z;
  unsigned sum, cnt, mine, sp = 0u;
  for (;;) {
    sum = 0u; cnt = 0u; mine = 0u;
#pragma unroll
    for (unsigned j = 0; j < 16; ++j) { const unsigned c = xb_ld(&bar[XB_XCNT(j)]); sum += c; cnt += (c > 0u) ? 1u : 0u; mine = (j == x) ? c : mine; }
    if (sum == G) break;
    __builtin_amdgcn_s_sleep(1);
    if ((++sp & 255u) == 0u) { if (xb_ld(&bar[XB_TMO])) break; if (sp > XB_SPIN_CAP) { atomicAdd(&bar[XB_TMO], 1u); break; } }
  }
  nloc = mine > 0u ? mine : 1u; nx = cnt > 0u ? cnt : 1u;
}
DI void xcd_barrier(const XcdBarrier& b) {
  asm volatile("s_waitcnt vmcnt(0)" ::: "memory");
  __syncthreads();
  if (threadIdx.x == 0) {
    size_t zb = 0; asm volatile("" : "+s"(zb));
    unsigned* bar = b.bar + zb;
    __builtin_amdgcn_s_waitcnt(0);
    unsigned nloc = b.st[0], nx = b.st[1];
    if (nloc == 0u) { xcd_barrier_complete(bar, b.x, nloc, nx); b.st[0] = nloc; b.st[1] = nx; }
    const unsigned old = xb_add(&bar[XB_XSUB(b.x)], 1u);
    const unsigned gen = old / nloc;
    if (old + 1u == (gen + 1u) * nloc) {
      __builtin_amdgcn_fence(__ATOMIC_RELEASE, "agent");
      asm volatile("s_waitcnt vmcnt(0)" ::: "memory");
      const unsigned og = xb_add(&bar[XB_TOP], 1u);
      const unsigned tg = og / nx;
      if (og + 1u == (tg + 1u) * nx) xb_add(&bar[XB_TOPGEN], 1u);
      else XB_SPIN(xb_ld(&bar[XB_TOPGEN]) == tg, bar);
      __builtin_amdgcn_fence(__ATOMIC_ACQUIRE, "agent");
      xb_add(&bar[XB_XGEN(b.x)], 1u);
      asm volatile("s_waitcnt vmcnt(0)" ::: "memory");
    } else {
      XB_SPIN(xb_ld(&bar[XB_XGEN(b.x)]) == gen, bar);
      __builtin_amdgcn_fence(__ATOMIC_ACQUIRE, "agent");
      asm volatile("s_waitcnt vmcnt(0)" ::: "memory");
    }
  }
  __syncthreads();
}

#define LAUNDER(q)  Params q = p; { size_t zoff = 0; asm volatile("" : "+s"(zoff)); q.ws = p.ws + zoff; q.xres = p.xres + zoff; q.x = p.x + zoff; }
#define PH_BEGIN(n) if (ph_lo <= (n) && (n) < ph_hi) { LAUNDER(q); char* ws = q.ws; (void)ws;
#define PH_END(n)   if ((n) + 1 < ph_hi) { xcd_barrier(xb); } }

__global__ void __launch_bounds__(512) mega(Params p, int ph_lo, int ph_hi) {
  extern __shared__ __attribute__((aligned(16))) unsigned char lds_raw[];
  LAS unsigned char* lds = (LAS unsigned char*)lds_raw;
  char* smem = (char*)lds_raw;
  const int nx = gridDim.x >> 3, xcd = blockIdx.x & 7, jx = blockIdx.x >> 3;
  volatile LAS unsigned* bst = (volatile LAS unsigned*)(lds + SM_BARST);
  if (threadIdx.x < 2) bst[threadIdx.x] = 0u;
  __syncthreads();
  const XcdBarrier xb = xcd_barrier_post((unsigned*)(p.ws + TB_BAR), bst);

  if (ph_lo < 0) cg::this_grid().sync();
  PH_BEGIN(0) phase_prep(q, smem); PH_END(0)

#pragma unroll 1
  for (int L = 0; L < 4; ++L) {
    const int pb = 1 + 8 * L, li = L >> 1;
    const bool even = (L & 1) == 0;
    if (even) {
      PH_BEGIN(pb + 1)
        run_gemm<EPI_ABIN>(lds, (const u16*)(ws + B_XR), (const u16*)(ws + W_ABIN) + (size_t)li * 2304 * 1024, 2304, 1024, q, nullptr, (const float*)(ws + TB_SSA), nullptr);
      PH_END(pb + 1)
      PH_BEGIN(pb + 2)
        run_gemm<EPI_UQ>(lds, (const u16*)(ws + B_BIG + E_CQ), (const u16*)(ws + W_UQ) + (size_t)li * 768 * 384, 768, 384, q, nullptr, nullptr, nullptr);
        run_gemm<EPI_UKV>(lds, (const u16*)(ws + B_BIG + E_CKV), (const u16*)(ws + W_UKV) + (size_t)li * 1024 * 256, 1024, 256, q, nullptr, nullptr, nullptr);
      PH_END(pb + 2)
      PH_BEGIN(pb + 3)
        if (jx < nx) {
          const int half = get_tid() >> 8;
          char* sm = smem + half * ATT_HALF;
#pragma unroll 1
          for (int u = jx; u < 128; u += nx) attn_mla_unit(q, xcd, u >> 4, u & 15, smem, u != jx, (u + nx) >> 4, u + nx < 128);
#pragma unroll 1
          for (int up = jx; up < 128; up += nx) { const int u = 2 * up + half; attn_na_unit(q, li, xcd, u >> 2, u & 3, sm); }
        }
      PH_END(pb + 3)
    } else {
      PH_BEGIN(pb + 1)
        run_gemm<EPI_CIN>(lds, (const u16*)(ws + B_XR), (const u16*)(ws + W_CIN) + (size_t)li * 3072 * 1024, 3072, 1024, q, nullptr, (const float*)(ws + TB_SSA), nullptr);
      PH_END(pb + 1)
      PH_BEGIN(pb + 3)
        if (jx < nx) {
          const int half = get_tid() >> 8;
          char* sm = smem + half * ATT_HALF;
#pragma unroll 1
          for (int u = jx; u < 256; u += nx) attn_diff_unit(q, li, xcd, u >> 5, u & 31, smem, u != jx, (u + nx) >> 5, u + nx < 256);
        }
      PH_END(pb + 3)
    }
    PH_BEGIN(pb + 4)
      run_gemm<EPI_RESID>(lds, (const u16*)(ws + B_H), (const u16*)(ws + (even ? W_ABOUT : W_COUT)) + (size_t)li * 1024 * 1024, 1024, 1024, q, (L == 0) ? q.x : nullptr, nullptr, (float*)(ws + TB_SSM));
    PH_END(pb + 4)
    PH_BEGIN(pb + 6)
      run_gemm<EPI_RELU2>(lds, (const u16*)(ws + B_XR), (const u16*)(ws + W_W1) + (size_t)L * 4096 * 1024, 4096, 1024, q, nullptr, (const float*)(ws + TB_SSM), nullptr);
    PH_END(pb + 6)
    PH_BEGIN(pb + 7)
      run_gemm<EPI_RESID>(lds, (const u16*)(ws + B_BIG), (const u16*)(ws + W_W2) + (size_t)L * 1024 * 4096, 1024, 4096, q, nullptr, nullptr, (float*)(ws + TB_SSA));
    PH_END(pb + 7)
  }

  PH_BEGIN(NPH - 1) phase_norm<true, true>(ws + B_XR, q.final_norm, nullptr, q.xres); PH_END(NPH - 1)
}

extern "C" void kernel_launch(void* const* d_in, const int* in_sizes, int n_in, void* d_out, int out_size,
                              void* d_ws, size_t ws_size, hipStream_t stream) {
  if (ws_size < WS_NEED) { fprintf(stderr, "workspace too small: %zu < %zu\n", ws_size, WS_NEED); return; }
  Params p{};
  p.x = (const float*)d_in[0]; p.norm_attn = (const float*)d_in[1]; p.norm_mlp = (const float*)d_in[2];
  p.ab_w_in = (const float*)d_in[3]; p.ab_q_norm = (const float*)d_in[4]; p.ab_w_uq = (const float*)d_in[5];
  p.ab_kv_norm = (const float*)d_in[6]; p.ab_w_ukv = (const float*)d_in[7]; p.ab_rpb = (const float*)d_in[8];
  p.ab_w_out = (const float*)d_in[9]; p.c_w_in = (const float*)d_in[10]; p.lq1 = (const float*)d_in[11];
  p.lk1 = (const float*)d_in[12]; p.lq2 = (const float*)d_in[13]; p.lk2 = (const float*)d_in[14];
  p.c_subln = (const float*)d_in[15]; p.c_w_out = (const float*)d_in[16]; p.t5 = (const float*)d_in[17];
  p.mlp_w1 = (const float*)d_in[18]; p.mlp_w2 = (const float*)d_in[19]; p.final_norm = (const float*)d_in[20];
  p.xres = (float*)d_out; p.ws = (char*)d_ws;

  static int grid_blocks = 0;
  if (!grid_blocks) {
    int dev = 0, cus = 0, per_cu = 0;
    (void)hipGetDevice(&dev);
    (void)hipDeviceGetAttribute(&cus, hipDeviceAttributeMultiprocessorCount, dev);
    if (hipFuncSetAttribute((const void*)mega, hipFuncAttributeMaxDynamicSharedMemorySize, SMEM_BYTES) != hipSuccess) { fprintf(stderr, "hipFuncSetAttribute failed\n"); grid_blocks = -1; return; }
    (void)hipOccupancyMaxActiveBlocksPerMultiprocessor(&per_cu, mega, NTHR, SMEM_BYTES);
    (void)hipGetLastError();
    grid_blocks = cus;
  }
  if (grid_blocks < 0) return;
#if MULTI_LAUNCH
  for (int ph = 0; ph < NPH; ++ph) {
    if (ph >= 1 && ph < NPH - 1 && ((ph - 1) & 7) == 2 && ((((ph - 1) >> 3) & 1) == 1)) continue;
    hipLaunchKernelGGL(mega, dim3(grid_blocks), dim3(NTHR), SMEM_BYTES, stream, p, ph, ph + 1);
  }
#else
  (void)hipMemsetAsync((char*)d_ws + TB_BAR, 0, 16384, stream);
  int lo = 0, hi = NPH;
  void* args[] = {&p, &lo, &hi};
  hipError_t e = hipLaunchCooperativeKernel((void*)mega, dim3(grid_blocks), dim3(NTHR), args, SMEM_BYTES, stream);
  if (e != hipSuccess) fprintf(stderr, "cooperative launch failed: %s (grid %d)\n", hipGetErrorString(e), grid_blocks);
#endif
}
```

```cpp
#include <hip/hip_runtime.h>
#include <hip/hip_cooperative_groups.h>
#include <cstdio>
namespace cg = cooperative_groups;

typedef unsigned short u16;
using bf16x8 = __attribute__((ext_vector_type(8))) short;
using s16x4  = __attribute__((ext_vector_type(4))) short;
using f32x4  = __attribute__((ext_vector_type(4))) float;
using f32x16 = __attribute__((ext_vector_type(16))) float;
using u32x4  = __attribute__((ext_vector_type(4))) unsigned;
using u32x2  = __attribute__((ext_vector_type(2))) unsigned;
typedef __bf16 bf2_t __attribute__((ext_vector_type(2)));
typedef float  fl2_t __attribute__((ext_vector_type(2)));
#define DI __device__ __forceinline__

#ifndef MULTI_LAUNCH
#define MULTI_LAUNCH 0
#endif

constexpr int T_ = 32768;
constexpr int S_ = 4096;
constexpr float LOG2E = 1.4426950408889634f;
constexpr float EPS = 1e-6f;
constexpr int NPH = 34;
constexpr int NTHR = 512;

constexpr size_t W_ABIN  = 0;
constexpr size_t W_UQ    = W_ABIN  + 2ull * 2304 * 1024 * 2;
constexpr size_t W_UKV   = W_UQ    + 2ull * 768 * 384 * 2;
constexpr size_t W_ABOUT = W_UKV   + 2ull * 1024 * 256 * 2;
constexpr size_t W_CIN   = W_ABOUT + 2ull * 1024 * 1024 * 2;
constexpr size_t W_COUT  = W_CIN   + 2ull * 3072 * 1024 * 2;
constexpr size_t W_W1    = W_COUT  + 2ull * 1024 * 1024 * 2;
constexpr size_t W_W2    = W_W1    + 4ull * 4096 * 1024 * 2;
constexpr size_t TB_COS  = W_W2    + 4ull * 4096 * 1024 * 2;
constexpr size_t TB_SIN  = TB_COS  + 4096ull * 16 * 4;
constexpr size_t TB_T5   = TB_SIN  + 4096ull * 16 * 4;
constexpr size_t TB_LAM  = TB_T5   + 8ull * 512 * 4;
constexpr size_t TB_SSA  = TB_LAM  + 256;
constexpr size_t TB_SSM  = TB_SSA  + (size_t)T_ * 16 * 4;
constexpr size_t TB_BAR  = TB_SSM  + (size_t)T_ * 16 * 4;
constexpr size_t B_H     = TB_BAR  + 16384;
constexpr size_t B_BIG   = B_H     + (size_t)T_ * 1024 * 2;
constexpr size_t E_CQ    = 0;
constexpr size_t E_CKV   = E_CQ    + (size_t)T_ * 384 * 2;
constexpr size_t E_KPE   = E_CKV   + (size_t)T_ * 256 * 2;
constexpr size_t E_QNA   = E_KPE   + (size_t)T_ * 32 * 2;
constexpr size_t E_KNA   = E_QNA   + (size_t)T_ * 512 * 2;
constexpr size_t E_VNAT  = E_KNA   + (size_t)T_ * 512 * 2;
constexpr size_t E_QMLA  = E_VNAT  + (size_t)T_ * 512 * 2;
constexpr size_t E_KNOPE = E_QMLA  + (size_t)T_ * 768 * 2;
constexpr size_t E_VMLAT = E_KNOPE + (size_t)T_ * 512 * 2;
constexpr size_t E_END   = E_VMLAT + (size_t)T_ * 512 * 2;
static_assert(E_END <= (size_t)T_ * 4096 * 2, "even buffers exceed BIG");
constexpr size_t O_QD    = 0;
constexpr size_t O_KD    = O_QD + (size_t)T_ * 1024 * 2;
constexpr size_t O_VDT   = O_KD + (size_t)T_ * 1024 * 2;
constexpr size_t B_XR    = B_BIG + (size_t)T_ * 4096 * 2;
constexpr size_t WS_NEED = B_XR + (size_t)T_ * 1024 * 2;

struct Params {
  const float* x; const float* norm_attn; const float* norm_mlp; const float* ab_w_in; const float* ab_q_norm;
  const float* ab_w_uq; const float* ab_kv_norm; const float* ab_w_ukv; const float* ab_rpb; const float* ab_w_out;
  const float* c_w_in; const float* lq1; const float* lk1; const float* lq2; const float* lk2; const float* c_subln;
  const float* c_w_out; const float* t5; const float* mlp_w1; const float* mlp_w2; const float* final_norm;
  float* xres; char* ws;
};

DI unsigned pack2(float a, float b) {
  fl2_t f = {a, b};
  bf2_t r = __builtin_convertvector(f, bf2_t);
  return __builtin_bit_cast(unsigned, r);
}
DI u16 f2bf(float x) { unsigned u = __float_as_uint(x); u += 0x7fffu + ((u >> 16) & 1u); return (u16)(u >> 16); }
DI float bf2f(unsigned v) { return __uint_as_float(v << 16); }
DI void st_bf4(u16* p, f32x4 v, float sc) {
  u32x2 u; u.x = pack2(v[0] * sc, v[1] * sc); u.y = pack2(v[2] * sc, v[3] * sc);
  *(u32x2*)p = u;
}
DI void st_bf8(u16* p, f32x4 a, f32x4 b, float sc) {
  u32x4 u; u.x = pack2(a[0] * sc, a[1] * sc); u.y = pack2(a[2] * sc, a[3] * sc); u.z = pack2(b[0] * sc, b[1] * sc); u.w = pack2(b[2] * sc, b[3] * sc);
  *(u32x4*)p = u;
}
DI void st_T(u16* p, f32x4 v, float sc) {
#pragma unroll
  for (int i = 0; i < 4; ++i) p[(size_t)i * S_] = f2bf(v[i] * sc);
}
DI int get_tid() { int t = threadIdx.x; asm volatile("" : "+v"(t)); return t; }
DI float shx(float v, int mask, int lane) {
  return __int_as_float(__builtin_amdgcn_ds_bpermute((lane ^ mask) << 2, __float_as_int(v)));
}
DI float wave_sum(float v, int lane) {
#pragma unroll
  for (int o = 32; o > 0; o >>= 1) v += shx(v, o, lane);
  return v;
}
DI f32x16 mfma32(bf16x8 a, bf16x8 b, f32x16 c) { return __builtin_amdgcn_mfma_f32_32x32x16_bf16(a, b, c, 0, 0, 0); }
DI f32x4 mfma16(bf16x8 a, bf16x8 b, f32x4 c) { return __builtin_amdgcn_mfma_f32_16x16x32_bf16(a, b, c, 0, 0, 0); }
DI bf16x8 pack8(const f32x16& s, int o) {
  u32x4 u;
  u.x = pack2(s[o + 0], s[o + 1]); u.y = pack2(s[o + 2], s[o + 3]);
  u.z = pack2(s[o + 4], s[o + 5]); u.w = pack2(s[o + 6], s[o + 7]);
  return __builtin_bit_cast(bf16x8, u);
}

DI void prep_wt(const float* __restrict__ src, u16* __restrict__ dst, int K, int N, int Npad,
                const float* __restrict__ gain, float* tile) {
  const int tid = get_tid();
  const int tk = K / 64, tn = Npad / 64, nt4 = tk * tn;
  constexpr int TS = 64 * 65;
  for (int t0 = blockIdx.x; t0 < nt4; t0 += 4 * gridDim.x) {
    f32x4 v[4][2];
#pragma unroll
    for (int j = 0; j < 4; ++j) {
      const int t = t0 + j * gridDim.x;
      const int kt = t % tk, nt = t / tk;
#pragma unroll
      for (int i = 0; i < 2; ++i) {
        const int e = tid + NTHR * i; const int kk = e >> 4, n4 = (e & 15) * 4; const int n = nt * 64 + n4;
        v[j][i] = (f32x4){0.f, 0.f, 0.f, 0.f};
        if (t < nt4 && n < N) {
          v[j][i] = *(const f32x4*)(src + (size_t)(kt * 64 + kk) * N + n);
          if (gain) v[j][i] *= gain[kt * 64 + kk];
        }
      }
    }
    __syncthreads();
#pragma unroll
    for (int j = 0; j < 4; ++j)
#pragma unroll
      for (int i = 0; i < 2; ++i) {
        const int e = tid + NTHR * i; const int kk = e >> 4, n4 = (e & 15) * 4;
        float* tp = tile + j * TS + kk * 65 + n4;
        tp[0] = v[j][i][0]; tp[1] = v[j][i][1]; tp[2] = v[j][i][2]; tp[3] = v[j][i][3];
      }
    __syncthreads();
#pragma unroll
    for (int j = 0; j < 4; ++j) {
      const int t = t0 + j * gridDim.x;
      if (t < nt4) {
        const int kt = t % tk, nt = t / tk;
        const int nn = tid >> 3, k8 = (tid & 7) * 8;
        const float* tp = tile + j * TS + k8 * 65 + nn;
        u32x4 u;
        u.x = pack2(tp[0 * 65], tp[1 * 65]); u.y = pack2(tp[2 * 65], tp[3 * 65]);
        u.z = pack2(tp[4 * 65], tp[5 * 65]); u.w = pack2(tp[6 * 65], tp[7 * 65]);
        *(u32x4*)(dst + (size_t)(nt * 64 + nn) * K + kt * 64 + k8) = u;
      }
    }
  }
}

DI int t5_bucket(int rel) {
  int ret = rel > 0 ? 16 : 0;
  int n = rel < 0 ? -rel : rel;
  int b;
  if (n < 8) b = n;
  else { int lg = 31 - __clz(n * n); b = 8 + lg - 6; if (b > 15) b = 15; }
  return ret + b;
}

DI void phase_prep(const Params& p, char* smem) {
  float* tile = (float*)smem;
  char* ws = p.ws;
  for (int i = 0; i < 2; ++i) {
    prep_wt(p.ab_w_in + (size_t)i * 1024 * 2208, (u16*)(ws + W_ABIN) + (size_t)i * 2304 * 1024, 1024, 2208, 2304, p.norm_attn + (2 * i) * 1024, tile);
    prep_wt(p.ab_w_uq + (size_t)i * 384 * 768, (u16*)(ws + W_UQ) + (size_t)i * 768 * 384, 384, 768, 768, p.ab_q_norm + i * 384, tile);
    prep_wt(p.ab_w_ukv + (size_t)i * 256 * 1024, (u16*)(ws + W_UKV) + (size_t)i * 1024 * 256, 256, 1024, 1024, p.ab_kv_norm + i * 256, tile);
    prep_wt(p.ab_w_out + (size_t)i * 1024 * 1024, (u16*)(ws + W_ABOUT) + (size_t)i * 1024 * 1024, 1024, 1024, 1024, nullptr, tile);
    prep_wt(p.c_w_in + (size_t)i * 1024 * 3072, (u16*)(ws + W_CIN) + (size_t)i * 3072 * 1024, 1024, 3072, 3072, p.norm_attn + (2 * i + 1) * 1024, tile);
    prep_wt(p.c_w_out + (size_t)i * 1024 * 1024, (u16*)(ws + W_COUT) + (size_t)i * 1024 * 1024, 1024, 1024, 1024, nullptr, tile);
  }
  for (int i = 0; i < 4; ++i) {
    prep_wt(p.mlp_w1 + (size_t)i * 1024 * 4096, (u16*)(ws + W_W1) + (size_t)i * 4096 * 1024, 1024, 4096, 4096, p.norm_mlp + i * 1024, tile);
    prep_wt(p.mlp_w2 + (size_t)i * 4096 * 1024, (u16*)(ws + W_W2) + (size_t)i * 1024 * 4096, 4096, 1024, 1024, nullptr, tile);
  }
  {
    const int t0 = get_tid(); const int wave = t0 >> 6, lane = t0 & 63;
    u16* xb = (u16*)(ws + B_XR); float* ssa = (float*)(ws + TB_SSA);
    for (int row = blockIdx.x * 8 + wave; row < T_; row += gridDim.x * 8) {
      const f32x4* xr = (const f32x4*)(p.x + (size_t)row * 1024);
      float ss = 0.f;
#pragma unroll
      for (int i = 0; i < 2; ++i) {
        const f32x4 a = xr[2 * lane + 128 * i], b = xr[2 * lane + 128 * i + 1];
        ss += a[0] * a[0] + a[1] * a[1] + a[2] * a[2] + a[3] * a[3] + b[0] * b[0] + b[1] * b[1] + b[2] * b[2] + b[3] * b[3];
        st_bf8(xb + (size_t)row * 1024 + 8 * lane + 512 * i, a, b, 1.f);
      }
      ss = wave_sum(ss, lane);
      if (lane < 16) ssa[(size_t)row * 16 + lane] = (lane == 0) ? ss : 0.f;
    }
  }
  const int gt = blockIdx.x * NTHR + get_tid(), gn = gridDim.x * NTHR;
  float* tcos = (float*)(ws + TB_COS); float* tsin = (float*)(ws + TB_SIN);
  for (int idx = gt; idx < 4096 * 16; idx += gn) {
    int pos = idx >> 4, j = idx & 15;
    float inv = exp2f(-(float)j * (13.287712379549449f / 16.0f));
    float ang = (float)pos * inv;
    tcos[idx] = cosf(ang);
    tsin[idx] = sinf(ang);
  }
  float* t5t = (float*)(ws + TB_T5);
  for (int idx = gt; idx < 8 * 512; idx += gn) {
    int h = idx >> 9, e = idx & 511; int rel = e - 255; if (rel > 255) rel = 255;
    t5t[idx] = p.t5[t5_bucket(rel) * 8 + h] * LOG2E;
  }
  if (gt < 2) {
    float s1 = 0.f, s2 = 0.f;
    for (int d = 0; d < 64; ++d) { s1 += p.lq1[gt * 64 + d] * p.lk1[gt * 64 + d]; s2 += p.lq2[gt * 64 + d] * p.lk2[gt * 64 + d]; }
    int layer = 2 * gt + 1;
    float li = 0.8f - 0.6f * expf(-0.3f * (float)layer);
    ((float*)(ws + TB_LAM))[gt] = expf(s1) - expf(s2) + li;
  }
}

template <bool FINAL, bool IN_BF16>
DI void phase_norm(const void* __restrict__ xin, const float* __restrict__ g, u16* __restrict__ h, float* __restrict__ outf) {
  const int tid = get_tid();
  const int wave = tid >> 6, lane = tid & 63;
  for (int row = blockIdx.x * 8 + wave; row < T_; row += gridDim.x * 8) {
    f32x4 v[4]; float ss = 0.f;
    if (IN_BF16) {
      const u32x4* xr = (const u32x4*)((const u16*)xin + (size_t)row * 1024);
#pragma unroll
      for (int i = 0; i < 2; ++i) {
        const u32x4 u = xr[lane + 64 * i];
        v[2 * i]     = (f32x4){bf2f(u.x & 0xffffu), bf2f(u.x >> 16), bf2f(u.y & 0xffffu), bf2f(u.y >> 16)};
        v[2 * i + 1] = (f32x4){bf2f(u.z & 0xffffu), bf2f(u.z >> 16), bf2f(u.w & 0xffffu), bf2f(u.w >> 16)};
      }
    } else {
      const f32x4* xr = (const f32x4*)((const float*)xin + (size_t)row * 1024);
#pragma unroll
      for (int i = 0; i < 2; ++i) { v[2 * i] = xr[2 * lane + 128 * i]; v[2 * i + 1] = xr[2 * lane + 128 * i + 1]; }
    }
#pragma unroll
    for (int i = 0; i < 4; ++i) ss += v[i][0] * v[i][0] + v[i][1] * v[i][1] + v[i][2] * v[i][2] + v[i][3] * v[i][3];
    ss = wave_sum(ss, lane);
    const float rinv = rsqrtf(ss * (1.f / 1024.f) + EPS);
#pragma unroll
    for (int i = 0; i < 2; ++i) {
      const f32x4 g0 = ((const f32x4*)g)[2 * lane + 128 * i], g1 = ((const f32x4*)g)[2 * lane + 128 * i + 1];
      const f32x4 a = v[2 * i] * g0 * rinv, b = v[2 * i + 1] * g1 * rinv;
      if (FINAL) {
        f32x4* op = (f32x4*)(outf + (size_t)row * 1024);
        op[2 * lane + 128 * i] = a; op[2 * lane + 128 * i + 1] = b;
      } else {
        st_bf8(h + (size_t)row * 1024 + 8 * lane + 512 * i, a, b, 1.f);
      }
    }
  }
}

constexpr int SM_ATT_V = 17408;
constexpr int SM_ATT_TAB = 17408 + 64 * 320;
constexpr int STAGE_LDS = 131072;
constexpr int SM_RINVTAB = STAGE_LDS;
constexpr int ATT_LDS = 2 * (128 * 272 + 128 * 320) + 2048;
constexpr int SM_BARST = ATT_LDS;
constexpr int SMEM_BYTES = ATT_LDS + 16;
static_assert(ATT_LDS >= STAGE_LDS + 4096, "LDS map");
constexpr int ATT_HALF = 45056;
#define LAS __attribute__((address_space(3)))

namespace pg8 {
constexpr int BM = 256, BK = 64, HALF = 128, HTB = HALF * BK * 2, NXCD = 8, WGM = 8;
DI int lds_byte(int r, int c) { const int st = (r >> 4) * 2 + (c >> 5), rr = r & 15, cc = c & 31, ob = rr * 64 + cc * 2; return st * 1024 + (ob ^ (((ob >> 9) & 1) << 5)); }
DI void stage_rc(int b, int& R, int& C) { const int st = b / 1024, sb = b % 1024, swz = sb ^ (((sb >> 9) & 1) << 5); R = (st >> 1) * 16 + swz / 64; C = (st & 1) * 32 + (swz % 64) / 2; }
DI int perm32(int rho) { const int n = rho >> 4, i = rho & 15; return 8 * (i >> 2) + 4 * n + (i & 3); }
struct Unit { int pm, pn; };
struct Gemm { const u16* A; const u16* Bt; int M, N, K; };
struct StaticOrder {
  int nM, nN, nwg, G, c, rev;
  DI void init(int M, int N, int G_, int c_) { nM = M / BM; nN = N / BM; nwg = nM * nN; G = G_; c = c_; rev = 0; }
  DI bool next(int i, Unit& u) const {
    if ((long)i * G + c >= nwg) return false;
    const int ii = (rev && (nwg % G) == 0) ? (nwg / G - 1 - i) : i;
    const long L = (long)ii * G + c;
    int wgid = (int)L; { const int q = nwg / NXCD, r = nwg % NXCD, xcd = wgid % NXCD, off = wgid / NXCD; wgid = (xcd < r ? xcd * (q + 1) : r * (q + 1) + (xcd - r) * q) + off; }
    const int nig = WGM * nN, gid = wgid / nig, fm = gid * WGM, gsz = (nM - fm) < WGM ? (nM - fm) : WGM;
    u.pm = fm + ((wgid % nig) % gsz); u.pn = (wgid % nig) / gsz; return true;
  }
};

template <class Epi, class Sched>
DI void gemm_phase(LAS unsigned char* lds, const Gemm g, const Sched& S, const Epi& E) {
  const int tid = get_tid(), wid = __builtin_amdgcn_readfirstlane(tid >> 6), lane = tid & 63, wr = wid >> 2, wc = wid & 3, fr = lane & 15, fq = lane >> 4;
  const int K = g.K, nt = K / BK;
  unsigned voffA[2], voffB[2];
#pragma unroll
  for (int i = 0; i < 2; ++i) { int R, C; stage_rc(tid * 16 + i * 8192, R, C); const int Rb = Epi::PERM ? ((R & ~31) + perm32(R & 31)) : R;
    voffA[i] = (unsigned)(R * K + C) * 2u; voffB[i] = (unsigned)(Rb * K + C) * 2u; }
  const size_t kstep = (size_t)(BK * 2);
  const size_t hstep = (size_t)HALF * K * 2;
  const size_t tstep = 2 * hstep;
  const unsigned ldsw = (unsigned)wid * 1024u;
  const int aoff = lds_byte(wr * 64 + fr, fq * 8), boff = lds_byte(wc * 32 + fr, fq * 8);
#define PG8_SA(b, h) (((b) * 2 + (h)) * HTB)
#define PG8_SB(b, h) ((4 + (b) * 2 + (h)) * HTB)
#define PG8_STAGE(bufoff, gbase, voff) do { _Pragma("unroll") for (int _i = 0; _i < 2; ++_i) \
    __builtin_amdgcn_global_load_lds((const unsigned*)((const char*)(gbase) + (voff)[_i]), (LAS unsigned*)(lds + (bufoff) + ldsw + _i * 8192), 16, 0, 0); } while (0)
#define PG8_LDA(dst, b, h) do { _Pragma("unroll") for (int m = 0; m < 4; ++m) _Pragma("unroll") for (int k = 0; k < 2; ++k) dst[m][k] = *(const LAS bf16x8*)(lds + PG8_SA(b, h) + aoff + m * 2048 + k * 1024); } while (0)
#define PG8_LDB(dst, b, h) do { _Pragma("unroll") for (int n = 0; n < 2; ++n) _Pragma("unroll") for (int k = 0; k < 2; ++k) dst[n][k] = *(const LAS bf16x8*)(lds + PG8_SB(b, h) + boff + n * 2048 + k * 1024); } while (0)
#define PG8_MMA(ai, bj, At, Bt) do { __builtin_amdgcn_s_setprio(1); _Pragma("unroll") for (int m = 0; m < 4; ++m) _Pragma("unroll") for (int n = 0; n < 2; ++n) _Pragma("unroll") for (int k = 0; k < 2; ++k) \
    acc[ai][bj][m][n] = __builtin_amdgcn_mfma_f32_16x16x32_bf16(Bt[n][k], At[m][k], acc[ai][bj][m][n], 0, 0, 0); __builtin_amdgcn_s_setprio(0); } while (0)
#define PG8_WAIT_V(n) asm volatile("s_waitcnt vmcnt(" #n ")" ::: "memory")
#define PG8_WAIT_L(n) asm volatile("s_waitcnt lgkmcnt(" #n ")" ::: "memory")
#define PG8_BAR __builtin_amdgcn_s_barrier()
#define PG8_SCHED __builtin_amdgcn_sched_barrier(0)
  Unit cur, nxt; int ui = 0;
  if (!S.next(0, cur)) return;
  f32x4 acc[2][2][4][2];
#pragma unroll
  for (int a = 0; a < 2; ++a)
#pragma unroll
    for (int b = 0; b < 2; ++b)
#pragma unroll
      for (int m = 0; m < 4; ++m)
#pragma unroll
        for (int n = 0; n < 2; ++n) acc[a][b][m][n] = (f32x4){0.f, 0.f, 0.f, 0.f};
  bf16x8 At[4][2], B0[2][2], B1[2][2];
  const char* cA = (const char*)g.A + (size_t)cur.pm * tstep; const char* cB = (const char*)g.Bt + (size_t)cur.pn * tstep;
  PG8_STAGE(PG8_SB(0, 0), cB, voffB); PG8_STAGE(PG8_SA(0, 0), cA, voffA); PG8_STAGE(PG8_SB(0, 1), cB + hstep, voffB); PG8_STAGE(PG8_SA(0, 1), cA + hstep, voffA);
  if (wr == 1) PG8_BAR;
  PG8_WAIT_V(4); PG8_BAR;
  PG8_STAGE(PG8_SB(1, 0), cB + kstep, voffB); PG8_STAGE(PG8_SA(1, 0), cA + kstep, voffA); PG8_STAGE(PG8_SB(1, 1), cB + hstep + kstep, voffB);
  PG8_WAIT_V(6); PG8_BAR;
  for (;;) {
    const bool has_next = S.next(ui + 1, nxt);
    const char* nA = has_next ? (const char*)g.A + (size_t)nxt.pm * tstep : cA; const char* nB = has_next ? (const char*)g.Bt + (size_t)nxt.pn * tstep : cB;
#pragma unroll 1
    for (int t = 0; t < nt; t += 2) {
      const bool last = (t == nt - 2);
      const char* a1 = cA + (size_t)(t + 1) * kstep;
      const char* a2 = last ? nA : cA + (size_t)(t + 2) * kstep; const char* b2 = last ? nB : cB + (size_t)(t + 2) * kstep;
      const char* a3 = a2 + kstep; const char* b3 = b2 + kstep;
      PG8_LDB(B0, 0, 0); PG8_SCHED; PG8_LDA(At, 0, 0); PG8_STAGE(PG8_SA(1, 1), a1 + hstep, voffA);
      PG8_WAIT_L(8); PG8_BAR; PG8_WAIT_L(0); PG8_MMA(0, 0, At, B0); PG8_BAR; PG8_SCHED;
      PG8_LDB(B1, 0, 1); PG8_STAGE(PG8_SB(0, 0), b2, voffB);
      PG8_BAR; PG8_WAIT_L(0); PG8_MMA(0, 1, At, B1); PG8_BAR;
      PG8_LDA(At, 0, 1); PG8_STAGE(PG8_SA(0, 0), a2, voffA);
      PG8_BAR; PG8_WAIT_L(0); PG8_MMA(1, 0, At, B0); PG8_BAR; PG8_SCHED;
      PG8_STAGE(PG8_SB(0, 1), b2 + hstep, voffB);
      PG8_WAIT_V(6); PG8_BAR; PG8_MMA(1, 1, At, B1); PG8_BAR;
      PG8_LDB(B0, 1, 0); PG8_SCHED; PG8_LDA(At, 1, 0); PG8_STAGE(PG8_SA(0, 1), a2 + hstep, voffA);
      PG8_WAIT_L(8); PG8_BAR; PG8_WAIT_L(0); PG8_MMA(0, 0, At, B0); PG8_BAR; PG8_SCHED;
      PG8_LDB(B1, 1, 1); PG8_STAGE(PG8_SB(1, 0), b3, voffB);
      PG8_BAR; PG8_WAIT_L(0); PG8_MMA(0, 1, At, B1); PG8_BAR;
      PG8_LDA(At, 1, 1); PG8_STAGE(PG8_SA(1, 0), a3, voffA);
      PG8_BAR; PG8_WAIT_L(0); PG8_MMA(1, 0, At, B0); PG8_BAR; PG8_SCHED;
      PG8_STAGE(PG8_SB(1, 1), b3 + hstep, voffB);
      PG8_WAIT_V(6); PG8_BAR; PG8_MMA(1, 1, At, B1); PG8_BAR;
    }
    E(acc, cur, wr, wc, fr, fq);
    if (!has_next) break;
#pragma unroll
    for (int a = 0; a < 2; ++a)
#pragma unroll
      for (int b = 0; b < 2; ++b)
#pragma unroll
        for (int m = 0; m < 4; ++m)
#pragma unroll
          for (int n = 0; n < 2; ++n) acc[a][b][m][n] = (f32x4){0.f, 0.f, 0.f, 0.f};
    cur = nxt; cA = nA; cB = nB; ++ui;
  }
  PG8_WAIT_V(0);
  if (wr == 0) PG8_BAR;
  PG8_BAR;
#undef PG8_SA
#undef PG8_SB
#undef PG8_STAGE
#undef PG8_LDA
#undef PG8_LDB
#undef PG8_MMA
#undef PG8_WAIT_V
#undef PG8_WAIT_L
#undef PG8_BAR
#undef PG8_SCHED
}
}

DI void rope_perm(f32x4& a0, f32x4& a1, int fq, int lane, const float* tcos, const float* tsin, int pos) {
  f32x4 p0, p1;
#pragma unroll
  for (int e = 0; e < 4; ++e) { p0[e] = shx(a0[e], 32, lane); p1[e] = shx(a1[e], 32, lane); }
  const int jb = 8 * (fq & 1);
  const f32x4 c0 = *(const f32x4*)(tcos + pos * 16 + jb), c1 = *(const f32x4*)(tcos + pos * 16 + jb + 4);
  const f32x4 s0 = *(const f32x4*)(tsin + pos * 16 + jb), s1 = *(const f32x4*)(tsin + pos * 16 + jb + 4);
  if (fq < 2) { a0 = a0 * c0 - p0 * s0; a1 = a1 * c1 - p1 * s1; }
  else        { a0 = a0 * c0 + p0 * s0; a1 = a1 * c1 + p1 * s1; }
}
enum { EPI_ABIN = 0, EPI_UQ = 1, EPI_UKV = 2, EPI_CIN = 3, EPI_RESID = 4, EPI_RELU2 = 5 };

template <int EPI> struct Epi {
  static constexpr bool PERM = true, AFTER_DRAIN = false;
  char* big; const float* rsrc; float* rdst; const float* tcos; const float* tsin;
  const LAS float* rinv_tab;
  u16* xr; float* ss_out;
  mutable int round;
  DI void operator()(const f32x4 (&acc)[2][2][4][2], const pg8::Unit& u, int wr, int wc, int fr_, int fq_) const {
    const int t_ = get_tid();
    const int fr = t_ & 15, fq = (t_ >> 4) & 3;
    const int slot = round; round = round + 1;
#pragma unroll
    for (int ai = 0; ai < 2; ++ai)
#pragma unroll
      for (int m = 0; m < 4; ++m) {
        const int rl = ai * 128 + wr * 64 + m * 16 + fr;
        const int token = u.pm * 256 + rl;
        float rinv = 1.f;
        if (EPI != EPI_RESID) rinv = rinv_tab[slot * 256 + rl];
        float ssq = 0.f;
#pragma unroll
        for (int bj = 0; bj < 2; ++bj)
#pragma unroll
          for (int n = 0; n < 2; ++n) {
            const int fb = u.pn * 256 + bj * 128 + wc * 32 + n * 16;
            const int f = fb + 4 * fq;
            const f32x4 v = acc[ai][bj][m][n];
            if (EPI == EPI_ABIN) {
              if (n == 0) {
                const int gb = u.pn * 256 + bj * 128 + wc * 32; const int f8 = gb + 8 * fq;
                const f32x4 v1 = acc[ai][bj][m][1];
                if (gb < 384) st_bf8((u16*)(big + E_CQ) + (size_t)token * 384 + f8, v, v1, rinv);
                else if (gb < 640) st_bf8((u16*)(big + E_CKV) + (size_t)token * 256 + (f8 - 384), v, v1, rinv);
                else if (gb < 672) {
                  f32x4 a0 = v, a1 = v1;
                  rope_perm(a0, a1, fq, t_ & 63, tcos, tsin, token & (S_ - 1));
                  st_bf8((u16*)(big + E_KPE) + (size_t)token * 32 + 8 * fq, a0, a1, rinv);
                }
                else if (gb < 1184) st_bf8((u16*)(big + E_QNA) + (size_t)token * 512 + (f8 - 672), v, v1, rinv * (0.125f * LOG2E));
                else if (gb < 1696) st_bf8((u16*)(big + E_KNA) + (size_t)token * 512 + (f8 - 1184), v, v1, rinv);
                else if (gb < 2208) st_bf8((u16*)(big + E_VNAT) + (size_t)token * 512 + (f8 - 1696), v, v1, rinv);
              }
            } else if (EPI == EPI_UQ) {
              if (n == 0) {
                const float sc = rinv * (0.10206207261596575f * LOG2E);
                const int gb = u.pn * 256 + bj * 128 + wc * 32;
                const int hd = gb / 96; const int within = gb - hd * 96;
                f32x4 a0 = v, a1 = acc[ai][bj][m][1];
                if (within == 64) rope_perm(a0, a1, fq, t_ & 63, tcos, tsin, token & (S_ - 1));
                st_bf8((u16*)(big + E_QMLA) + (size_t)token * 768 + gb + 8 * fq, a0, a1, sc);
              }
            } else if (EPI == EPI_UKV) {
              if (n == 0) {
                const int gb = u.pn * 256 + bj * 128 + wc * 32;
                const int hd = gb >> 7, within = (gb & 127) + 8 * fq;
                const f32x4 v1 = acc[ai][bj][m][1];
                if (within < 64) st_bf8((u16*)(big + E_KNOPE) + (size_t)token * 512 + hd * 64 + within, v, v1, rinv);
                else st_bf8((u16*)(big + E_VMLAT) + (size_t)token * 512 + hd * 64 + (within - 64), v, v1, rinv);
              }
            } else if (EPI == EPI_CIN) {
              if (n == 0) {
                const int gb = u.pn * 256 + bj * 128 + wc * 32;
                const int f8 = gb + 8 * fq;
                const f32x4 v1 = acc[ai][bj][m][1];
                if (gb < 1024) st_bf8((u16*)(big + O_QD) + (size_t)token * 1024 + f8, v, v1, rinv * (0.125f * LOG2E));
                else if (gb < 2048) st_bf8((u16*)(big + O_KD) + (size_t)token * 1024 + (f8 - 1024), v, v1, rinv);
                else st_bf8((u16*)(big + O_VDT) + (size_t)token * 1024 + (f8 - 2048), v, v1, rinv);
              }
            } else if (EPI == EPI_RESID) {
              if (n == 0) {
                const int f8 = u.pn * 256 + bj * 128 + wc * 32 + 8 * fq;
                const f32x4 v1 = acc[ai][bj][m][1];
                f32x4 r0, r1;
                if (rsrc) {
                  r0 = *(const f32x4*)(rsrc + (size_t)token * 1024 + f8); r1 = *(const f32x4*)(rsrc + (size_t)token * 1024 + f8 + 4);
                } else {
                  const u32x4 xu = *(const u32x4*)(xr + (size_t)token * 1024 + f8);
                  r0 = (f32x4){bf2f(xu.x & 0xffffu), bf2f(xu.x >> 16), bf2f(xu.y & 0xffffu), bf2f(xu.y >> 16)};
                  r1 = (f32x4){bf2f(xu.z & 0xffffu), bf2f(xu.z >> 16), bf2f(xu.w & 0xffffu), bf2f(xu.w >> 16)};
                }
                r0 += v; r1 += v1;
                st_bf8(xr + (size_t)token * 1024 + f8, r0, r1, 1.f);
                ssq += r0[0] * r0[0] + r0[1] * r0[1] + r0[2] * r0[2] + r0[3] * r0[3] + r1[0] * r1[0] + r1[1] * r1[1] + r1[2] * r1[2] + r1[3] * r1[3];
              }
            } else {
              if (n == 0) {
                const f32x4 v1 = acc[ai][bj][m][1];
                u32x4 o4;
                { const float t0 = fmaxf(v[0], 0.f) * rinv, t1 = fmaxf(v[1], 0.f) * rinv, t2 = fmaxf(v[2], 0.f) * rinv, t3 = fmaxf(v[3], 0.f) * rinv;
                  o4.x = pack2(t0 * t0, t1 * t1); o4.y = pack2(t2 * t2, t3 * t3); }
                { const float t0 = fmaxf(v1[0], 0.f) * rinv, t1 = fmaxf(v1[1], 0.f) * rinv, t2 = fmaxf(v1[2], 0.f) * rinv, t3 = fmaxf(v1[3], 0.f) * rinv;
                  o4.z = pack2(t0 * t0, t1 * t1); o4.w = pack2(t2 * t2, t3 * t3); }
                *(u32x4*)((u16*)big + (size_t)token * 4096 + u.pn * 256 + bj * 128 + wc * 32 + 8 * fq) = o4;
              }
            }
          }
        if (EPI == EPI_RESID) {
          ssq += shx(ssq, 16, t_ & 63);
          ssq += shx(ssq, 32, t_ & 63);
          if (fq == 0) ss_out[(size_t)token * 16 + u.pn * 4 + wc] = ssq;
        }
      }
  }
};

DI void rinv_prepass(const u16* __restrict__ A, int K, const pg8::StaticOrder& S, LAS float* tab) {
  const int tid = get_tid();
  const int row = tid >> 1, half = tid & 1;
  pg8::Unit u;
  for (int i = 0; i < 4 && S.next(i, u); ++i) {
    const u16* pr = A + (size_t)(u.pm * 256 + row) * K + half * (K >> 1);
    float ss = 0.f;
    for (int c = 0; c < (K >> 1); c += 8) {
      u32x4 w = *(const u32x4*)(pr + c);
      float a;
      a = bf2f(w.x & 0xffffu); ss += a * a; a = bf2f(w.x >> 16); ss += a * a;
      a = bf2f(w.y & 0xffffu); ss += a * a; a = bf2f(w.y >> 16); ss += a * a;
      a = bf2f(w.z & 0xffffu); ss += a * a; a = bf2f(w.z >> 16); ss += a * a;
      a = bf2f(w.w & 0xffffu); ss += a * a; a = bf2f(w.w >> 16); ss += a * a;
    }
    ss += shx(ss, 1, tid & 63);
    if (!half) tab[i * 256 + row] = rsqrtf(ss / (float)K + EPS);
  }
  __syncthreads();
}

DI void norm_prepass(const float* __restrict__ ss, const pg8::StaticOrder& S, LAS float* tab) {
  const int tid = get_tid();
  const int row = tid >> 1, half = tid & 1;
  pg8::Unit u;
  for (int i = 0; i < 8 && S.next(i, u); ++i) {
    const f32x4* sp = (const f32x4*)(ss + (size_t)(u.pm * 256 + row) * 16 + half * 8);
    const f32x4 a = sp[0], b = sp[1];
    float t = a[0]; t += a[1]; t += a[2]; t += a[3]; t += b[0]; t += b[1]; t += b[2]; t += b[3];
    const float o = shx(t, 1, tid & 63);
    const float tot = half ? (o + t) : (t + o);
    if (!half) tab[i * 256 + row] = rsqrtf(tot * (1.f / 1024.f) + EPS);
  }
  __syncthreads();
}

template <int EPI>
DI void run_gemm(LAS unsigned char* lds, const u16* A, const u16* Bt, int N, int K, const Params& q, const float* rsrc,
                 const float* ss_in, float* ss_out) {
  pg8::Gemm g; g.A = A; g.Bt = Bt; g.M = T_; g.N = N; g.K = K;
  pg8::StaticOrder S; S.init(T_, N, gridDim.x, blockIdx.x);
  if (EPI == EPI_RESID && K == 4096) S.rev = 1;
  Epi<EPI> E;
  E.big = q.ws + B_BIG; E.rsrc = rsrc; E.rdst = q.xres;
  E.tcos = (const float*)(q.ws + TB_COS); E.tsin = (const float*)(q.ws + TB_SIN);
  E.rinv_tab = (const LAS float*)(lds + SM_RINVTAB); E.round = 0;
  E.xr = (u16*)(q.ws + B_XR); E.ss_out = ss_out;
  if (EPI == EPI_UQ || EPI == EPI_UKV) rinv_prepass(A, K, S, (LAS float*)(lds + SM_RINVTAB));
  if (EPI == EPI_ABIN || EPI == EPI_CIN || EPI == EPI_RELU2) norm_prepass(ss_in, S, (LAS float*)(lds + SM_RINVTAB));
  pg8::gemm_phase(lds, g, S, E);
}

DI bool softmax_tile(f32x16& s0, f32x16& s1, float& m, float& l, float& alpha, bf16x8* pf, int lane, bool first, bool check) {
  if (first) {
    float mx = fmaxf(s0[0], s1[0]);
#pragma unroll
    for (int i = 1; i < 16; ++i) mx = fmaxf(mx, fmaxf(s0[i], s1[i]));
    mx = fmaxf(mx, shx(mx, 32, lane));
    m += mx;
#pragma unroll
    for (int i = 0; i < 16; ++i) { s0[i] -= mx; s1[i] -= mx; }
  }
  float sum = 0.f;
#pragma unroll
  for (int i = 0; i < 16; ++i) { s0[i] = __builtin_amdgcn_exp2f(s0[i]); sum += s0[i]; }
#pragma unroll
  for (int i = 0; i < 16; ++i) { s1[i] = __builtin_amdgcn_exp2f(s1[i]); sum += s1[i]; }
  l += sum;
  pf[0] = pack8(s0, 0); pf[1] = pack8(s0, 8); pf[2] = pack8(s1, 0); pf[3] = pack8(s1, 8);
  alpha = 1.f;
  if (!check) return false;
  const float rsum = sum + shx(sum, 32, lane);
  const bool trig = rsum > 65536.f;
  const bool resc = (__builtin_amdgcn_ballot_w64(trig) != 0ull);
  alpha = 1.f;
  if (resc) {
    const float d = trig ? (float)(__builtin_amdgcn_frexp_expf(rsum) - 7) : 0.f;
    alpha = __builtin_amdgcn_exp2f(-d);
    m += d; l *= alpha;
  }
  return resc;
}
DI int tr_base(int lane, int RS) {
  const int hh = lane >> 5, g1 = (lane >> 4) & 1, q = (lane >> 2) & 3, pp = lane & 3;
  return (4 * hh + q) * RS + (16 * g1 + 4 * pp) * 2;
}
DI bf16x8 ld_vfrag_tr(const char* vs, int vbase, int RS, int koff, int coff) {
  const char* a = vs + vbase + koff * RS + coff * 2;
  const s16x4 lo = __builtin_amdgcn_ds_read_tr16_b64_v4i16((LAS s16x4*)a);
  const s16x4 hi = __builtin_amdgcn_ds_read_tr16_b64_v4i16((LAS s16x4*)(a + 8 * RS));
  return __builtin_shufflevector(lo, hi, 0, 1, 2, 3, 4, 5, 6, 7);
}
DI bf16x8 ld_vfrag_s(const char* vs, int stride, int dvrow, int keyoff, int s, int hh) {
  const char* a = vs + dvrow * stride + (keyoff + 16 * s + 4 * hh) * 2;
  s16x4 lo = *(const s16x4*)a;
  s16x4 hi = *(const s16x4*)(a + 16);
  return __builtin_shufflevector(lo, hi, 0, 1, 2, 3, 4, 5, 6, 7);
}
DI void st_vt_s(char* vs, int stride, int dvrow, int part, u32x4 v) {
  char* a = vs + dvrow * stride + part * 16;
  *(u32x2*)a = (u32x2){v.x, v.y};
  *(u32x2*)(a + 8) = (u32x2){v.z, v.w};
}
DI bf16x8 ld_vfrag(const char* vs, int dvrow, int s, int hh) {
  const char* a = vs + dvrow * 136 + (16 * s + 4 * hh) * 2;
  s16x4 lo = *(const s16x4*)a;
  s16x4 hi = *(const s16x4*)(a + 16);
  return __builtin_shufflevector(lo, hi, 0, 1, 2, 3, 4, 5, 6, 7);
}
DI void st_vt(char* vs, int dvrow, int part, u32x4 v) {
  char* a = vs + dvrow * 136 + part * 16;
  *(u32x2*)a = (u32x2){v.x, v.y};
  *(u32x2*)(a + 8) = (u32x2){v.z, v.w};
}
DI void scale16(f32x16& o, float a) {
#pragma unroll
  for (int i = 0; i < 16; ++i) o[i] *= a;
}

DI void attn_mla_unit(const Params& p, int b, int h, int qb, char* smem, bool pre, int nh, bool has_next) {
  const int tid = get_tid(), lane = tid & 63, w = tid >> 6, r32 = lane & 31, hh = lane >> 5;
  char* big = p.ws + B_BIG;
  const u16* qmla = (const u16*)(big + E_QMLA);
  const u16* knope = (const u16*)(big + E_KNOPE);
  const u16* kpe = (const u16*)(big + E_KPE);
  const u16* vT = (const u16*)(big + E_VMLAT);
  u16* o = (u16*)(p.ws + B_H);
  constexpr int KR = 208, VR = 192;
  constexpr int STG = 128 * KR + 128 * VR;
  const int vbase = tr_base(lane, VR);
  const int qrow = b * S_ + qb * 256 + w * 32 + r32;
  bf16x8 qf[6];
#pragma unroll
  for (int s = 0; s < 6; ++s) qf[s] = *(const bf16x8*)(qmla + (size_t)qrow * 768 + h * 96 + s * 16 + hh * 8);
  f32x16 O0, O1;
#pragma unroll
  for (int i = 0; i < 16; ++i) { O0[i] = 0.f; O1[i] = 0.f; }
  float m = 0.f, l = 0.f;
  const int krow = tid >> 3, kpart = tid & 7;
  const int prow = tid >> 2, ppart = tid & 3;
  const int vrow = tid >> 3, vpart = tid & 7;
  const u16* gk = knope + (size_t)(b * S_ + krow) * 512 + h * 64 + kpart * 8;
  const u16* gp = kpe + (size_t)(b * S_ + prow) * 32 + ppart * 8;
  const u16* gv = vT + (size_t)(b * S_ + vrow) * 512 + h * 64 + vpart * 8;
  u32x4 rk[2], rp, rv[2];
  if (!pre) {
#pragma unroll
    for (int i = 0; i < 2; ++i) { rk[i] = *(const u32x4*)(gk + (size_t)i * 64 * 512); rv[i] = *(const u32x4*)(gv + (size_t)i * 64 * 512); }
    rp = *(const u32x4*)gp;
  }
  auto put_stage = [&](char* kb) {
    char* vb = kb + 128 * KR;
#pragma unroll
    for (int i = 0; i < 2; ++i) {
      *(u32x4*)(kb + (krow + 64 * i) * KR + kpart * 16) = rk[i];
      *(u32x4*)(vb + (vrow + 64 * i) * VR + vpart * 16) = rv[i];
    }
    *(u32x4*)(kb + prow * KR + 128 + ppart * 16) = rp;
  };
  auto get_stage = [&](int st) {
    const int k0 = st * 128;
#pragma unroll
    for (int i = 0; i < 2; ++i) { rk[i] = *(const u32x4*)(gk + (size_t)(k0 + i * 64) * 512); rv[i] = *(const u32x4*)(gv + (size_t)(k0 + i * 64) * 512); }
    rp = *(const u32x4*)(gp + (size_t)k0 * 32);
  };
  __syncthreads();
  if (!pre) put_stage(smem);
  __syncthreads();
  get_stage(1);
  for (int kt = 0; kt < 32; ++kt) {
    const char* ks = smem + (kt & 1) * STG; const char* vs = ks + 128 * KR;
#pragma unroll
    for (int sub = 0; sub < 2; ++sub) {
      f32x16 s0, s1;
#pragma unroll
      for (int i = 0; i < 16; ++i) { s0[i] = -m; s1[i] = -m; }
      {
        bf16x8 kf[12];
#pragma unroll
        for (int s = 0; s < 6; ++s) {
          kf[2 * s] = *(const bf16x8*)(ks + (sub * 64 + r32) * KR + (s * 16 + hh * 8) * 2);
          kf[2 * s + 1] = *(const bf16x8*)(ks + (sub * 64 + 32 + r32) * KR + (s * 16 + hh * 8) * 2);
        }
        __builtin_amdgcn_sched_barrier(0); __builtin_amdgcn_s_setprio(1);
#pragma unroll
        for (int s = 0; s < 6; ++s) { s0 = mfma32(kf[2 * s], qf[s], s0); s1 = mfma32(kf[2 * s + 1], qf[s], s1); }
      __builtin_amdgcn_s_setprio(0);
}
      float alpha; bf16x8 pf[4];
      const bool resc = softmax_tile(s0, s1, m, l, alpha, pf, lane, (kt == 0) && (sub == 0), sub == 0);
      {
        bf16x8 vf[8];
#pragma unroll
        for (int s = 0; s < 4; ++s) { vf[2 * s] = ld_vfrag_tr(vs, vbase, VR, sub * 64 + 16 * s, 0); vf[2 * s + 1] = ld_vfrag_tr(vs, vbase, VR, sub * 64 + 16 * s, 32); }
        __builtin_amdgcn_sched_barrier(0); __builtin_amdgcn_s_setprio(1);
#pragma unroll
        for (int s = 0; s < 4; ++s) { O0 = mfma32(vf[2 * s], pf[s], O0); O1 = mfma32(vf[2 * s + 1], pf[s], O1); }
      __builtin_amdgcn_s_setprio(0);
}
      if (resc) { scale16(O0, alpha); scale16(O1, alpha); }
    }
    if (kt + 1 < 32) put_stage(smem + ((kt + 1) & 1) * STG);
    else if (has_next) put_stage(smem);
    __syncthreads();
    if (kt + 2 < 32) get_stage(kt + 2);
    else if (kt == 30 && has_next) { gk += (nh - h) * 64; gv += (nh - h) * 64; get_stage(0); }
  }
  const float lt = l + shx(l, 32, lane);
  const float inv = 1.f / lt;
  u16* op = o + (size_t)qrow * 1024 + h * 64 + 4 * hh;
#pragma unroll
  for (int i4 = 0; i4 < 4; ++i4) {
    st_bf4(op + 8 * i4, (f32x4){O0[4 * i4], O0[4 * i4 + 1], O0[4 * i4 + 2], O0[4 * i4 + 3]}, inv);
    st_bf4(op + 32 + 8 * i4, (f32x4){O1[4 * i4], O1[4 * i4 + 1], O1[4 * i4 + 2], O1[4 * i4 + 3]}, inv);
  }
}

DI void attn_na_unit(const Params& p, int li, int b, int r, int hp, char* smem) {
  const int tid = get_tid() & 255, lane = tid & 63, w = tid >> 6, r32 = lane & 31, hh = lane >> 5;
  char* big = p.ws + B_BIG;
  const u16* qna = (const u16*)(big + E_QNA);
  const u16* kna = (const u16*)(big + E_KNA);
  const u16* vT = (const u16*)(big + E_VNAT);
  u16* o = (u16*)(p.ws + B_H);
  char* ks = smem; char* vs = smem + SM_ATT_V; float* tab = (float*)(smem + SM_ATT_TAB);
  constexpr int KR = 272, VR = 320;
  const int vbase = tr_base(lane, VR);
  const int qbk = w & 1, hs = w >> 1, head = 2 * hp + hs;
  const int wq = 32 * qbk + r32;
  const int qrow = b * S_ + r * 64 + wq;
  int cs = wq - 8; cs = cs < 0 ? 0 : (cs > 48 ? 48 : cs);
  int rs = r - 4; rs = rs < 0 ? 0 : (rs > 56 ? 56 : rs);
  __syncthreads();
  for (int idx = tid; idx < 2 * 465; idx += 256) {
    int hsel = idx >= 465 ? 1 : 0; int rem = idx - hsel * 465;
    tab[idx] = p.ab_rpb[((size_t)(li * 8 + 2 * hp + hsel)) * 465 + rem] * LOG2E;
  }
  bf16x8 qf[4];
#pragma unroll
  for (int s = 0; s < 4; ++s) qf[s] = *(const bf16x8*)(qna + (size_t)qrow * 512 + head * 64 + s * 16 + hh * 8);
  f32x16 O0, O1;
#pragma unroll
  for (int i = 0; i < 16; ++i) { O0[i] = 0.f; O1[i] = 0.f; }
  float m = 0.f, l = 0.f;
  const int krow = tid >> 4, kpart = tid & 15;
  const u16* gk = kna + (size_t)(b * S_ + rs * 64 + krow) * 512 + hp * 128 + kpart * 8;
  const u16* gv = vT + (size_t)(b * S_ + rs * 64 + krow) * 512 + hp * 128 + kpart * 8;
  u32x4 rk[4], rv[4];
#pragma unroll
  for (int i = 0; i < 4; ++i) { rk[i] = *(const u32x4*)(gk + (size_t)i * 16 * 512); rv[i] = *(const u32x4*)(gv + (size_t)i * 16 * 512); }
  for (int kt = 0; kt < 8; ++kt) {
    __syncthreads();
#pragma unroll
    for (int i = 0; i < 4; ++i) {
      *(u32x4*)(ks + (krow + 16 * i) * KR + kpart * 16) = rk[i];
      *(u32x4*)(vs + (krow + 16 * i) * VR + kpart * 16) = rv[i];
    }
    __syncthreads();
    if (kt + 1 < 8) {
      const int k0 = (kt + 1) * 64;
#pragma unroll
      for (int i = 0; i < 4; ++i) { rk[i] = *(const u32x4*)(gk + (size_t)(k0 + i * 16) * 512); rv[i] = *(const u32x4*)(gv + (size_t)(k0 + i * 16) * 512); }
    }
    f32x16 s0, s1;
#pragma unroll
    for (int i = 0; i < 16; ++i) { s0[i] = -m; s1[i] = -m; }
    {
      bf16x8 kf[8];
#pragma unroll
      for (int s = 0; s < 4; ++s) {
        kf[2 * s] = *(const bf16x8*)(ks + r32 * KR + (hs * 64 + s * 16 + hh * 8) * 2);
        kf[2 * s + 1] = *(const bf16x8*)(ks + (32 + r32) * KR + (hs * 64 + s * 16 + hh * 8) * 2);
      }
      __builtin_amdgcn_sched_barrier(0); __builtin_amdgcn_s_setprio(1);
#pragma unroll
      for (int s = 0; s < 4; ++s) { s0 = mfma32(kf[2 * s], qf[s], s0); s1 = mfma32(kf[2 * s + 1], qf[s], s1); }
    __builtin_amdgcn_s_setprio(0);
}
    const int drow = rs + kt - r + 7;
    const float* trow = tab + hs * 465 + drow * 31;
#pragma unroll
    for (int i = 0; i < 16; ++i) {
      const int kc0 = (i & 3) + 8 * (i >> 2) + 4 * hh;
      const int kc1 = kc0 + 32;
      const bool v0 = (unsigned)(kc0 - cs) < 16u;
      const bool v1 = (unsigned)(kc1 - cs) < 16u;
      const int d0 = v0 ? (kc0 - wq + 15) : 0;
      const int d1 = v1 ? (kc1 - wq + 15) : 0;
      const float b0 = trow[d0], b1 = trow[d1];
      s0[i] = v0 ? s0[i] + b0 : -1e30f;
      s1[i] = v1 ? s1[i] + b1 : -1e30f;
    }
    float alpha; bf16x8 pf[4];
    const bool resc = softmax_tile(s0, s1, m, l, alpha, pf, lane, kt == 0, true);
    {
      bf16x8 vf[8];
#pragma unroll
      for (int s = 0; s < 4; ++s) { vf[2 * s] = ld_vfrag_tr(vs, vbase, VR, 16 * s, hs * 64); vf[2 * s + 1] = ld_vfrag_tr(vs, vbase, VR, 16 * s, hs * 64 + 32); }
      __builtin_amdgcn_sched_barrier(0); __builtin_amdgcn_s_setprio(1);
#pragma unroll
      for (int s = 0; s < 4; ++s) { O0 = mfma32(vf[2 * s], pf[s], O0); O1 = mfma32(vf[2 * s + 1], pf[s], O1); }
    __builtin_amdgcn_s_setprio(0);
}
    if (resc) { scale16(O0, alpha); scale16(O1, alpha); }
  }
  const float lt = l + shx(l, 32, lane);
  const float inv = 1.f / lt;
  u16* op = o + (size_t)qrow * 1024 + 512 + head * 64 + 4 * hh;
#pragma unroll
  for (int i4 = 0; i4 < 4; ++i4) {
    st_bf4(op + 8 * i4, (f32x4){O0[4 * i4], O0[4 * i4 + 1], O0[4 * i4 + 2], O0[4 * i4 + 3]}, inv);
    st_bf4(op + 32 + 8 * i4, (f32x4){O1[4 * i4], O1[4 * i4 + 1], O1[4 * i4 + 2], O1[4 * i4 + 3]}, inv);
  }
}

DI void attn_diff_unit(const Params& p, int li, int b, int h, int qb, char* smem, bool pre, int nh, bool has_next) {
  const int tid = get_tid(), lane = tid & 63, w = tid >> 6, r32 = lane & 31, hh = lane >> 5;
  char* big = p.ws + B_BIG;
  const u16* qd = (const u16*)(big + O_QD);
  const u16* kd = (const u16*)(big + O_KD);
  const u16* vT = (const u16*)(big + O_VDT);
  u16* o = (u16*)(p.ws + B_H);
  constexpr int KR = 272, VR = 320;
  constexpr int STG = 128 * KR + 128 * VR;
  const int vbase = tr_base(lane, VR);
  float* tab = (float*)(smem + 2 * STG);
  const int rg = w & 3, map = w >> 2;
  const int qpos = qb * 128 + rg * 32 + r32;
  const int qrow = b * S_ + qpos;
  __syncthreads();
  const float* t5t = (const float*)(p.ws + TB_T5) + h * 512;
  if (tid < 512) tab[tid] = t5t[tid];
  const float cL = t5t[0], cR = t5t[510];
  bf16x8 qf[4];
#pragma unroll
  for (int s = 0; s < 4; ++s) qf[s] = *(const bf16x8*)(qd + (size_t)qrow * 1024 + h * 128 + map * 64 + s * 16 + hh * 8);
  f32x16 O[4];
#pragma unroll
  for (int j = 0; j < 4; ++j)
#pragma unroll
    for (int i = 0; i < 16; ++i) O[j][i] = 0.f;
  float m = 0.f, l = 0.f;
  const int krow = tid >> 4, kpart = tid & 15;
  const u16* gk = kd + (size_t)(b * S_ + krow) * 1024 + h * 128 + kpart * 8;
  const u16* gv = vT + (size_t)(b * S_ + krow) * 1024 + h * 128 + kpart * 8;
  u32x4 rk[4], rv[4];
  if (!pre) {
#pragma unroll
    for (int i = 0; i < 4; ++i) { rk[i] = *(const u32x4*)(gk + (size_t)i * 32 * 1024); rv[i] = *(const u32x4*)(gv + (size_t)i * 32 * 1024); }
  }
  auto put_stage = [&](char* kb) {
    char* vb = kb + 128 * KR;
#pragma unroll
    for (int i = 0; i < 4; ++i) {
      *(u32x4*)(kb + (krow + 32 * i) * KR + kpart * 16) = rk[i];
      *(u32x4*)(vb + (krow + 32 * i) * VR + kpart * 16) = rv[i];
    }
  };
  auto get_stage = [&](int st) {
    const int k0 = st * 128;
#pragma unroll
    for (int i = 0; i < 4; ++i) { rk[i] = *(const u32x4*)(gk + (size_t)(k0 + i * 32) * 1024); rv[i] = *(const u32x4*)(gv + (size_t)(k0 + i * 32) * 1024); }
  };
  if (!pre) put_stage(smem);
  __syncthreads();
  get_stage(1);
  for (int kt = 0; kt < 32; ++kt) {
    const char* ks = smem + (kt & 1) * STG; const char* vs = ks + 128 * KR;
#pragma unroll
    for (int sub = 0; sub < 2; ++sub) {
      const int kbase = kt * 128 + sub * 64;
      const int relmin = kbase - (qb * 128 + 127), relmax = kbase + 63 - qb * 128;
      const float cb = (relmin >= 128) ? cR : ((relmax <= -128) ? cL : 0.f);
      f32x16 s0, s1;
#pragma unroll
      for (int i = 0; i < 16; ++i) { s0[i] = cb - m; s1[i] = cb - m; }
      {
        bf16x8 kf[8];
#pragma unroll
        for (int s = 0; s < 4; ++s) {
          kf[2 * s] = *(const bf16x8*)(ks + (sub * 64 + r32) * KR + (map * 64 + s * 16 + hh * 8) * 2);
          kf[2 * s + 1] = *(const bf16x8*)(ks + (sub * 64 + 32 + r32) * KR + (map * 64 + s * 16 + hh * 8) * 2);
        }
        __builtin_amdgcn_sched_barrier(0); __builtin_amdgcn_s_setprio(1);
#pragma unroll
        for (int s = 0; s < 4; ++s) { s0 = mfma32(kf[2 * s], qf[s], s0); s1 = mfma32(kf[2 * s + 1], qf[s], s1); }
      __builtin_amdgcn_s_setprio(0);
}
      if (relmin < 128 && relmax > -128) {
        const int base = kbase - qpos + 255 + 4 * hh;
#pragma unroll
        for (int i = 0; i < 16; ++i) {
          int i0 = base + (i & 3) + 8 * (i >> 2);
          int i1 = i0 + 32;
          i0 = i0 < 0 ? 0 : (i0 > 510 ? 510 : i0);
          i1 = i1 < 0 ? 0 : (i1 > 510 ? 510 : i1);
          s0[i] += tab[i0]; s1[i] += tab[i1];
        }
      }
      float alpha; bf16x8 pf[4];
      const bool resc = softmax_tile(s0, s1, m, l, alpha, pf, lane, (kt == 0) && (sub == 0), sub == 0);
      {
        bf16x8 vf[2][4];
#pragma unroll
        for (int j = 0; j < 4; ++j) vf[0][j] = ld_vfrag_tr(vs, vbase, VR, sub * 64, j * 32);
#pragma unroll
        for (int s = 0; s < 4; ++s) {
          if (s < 3) {
#pragma unroll
            for (int j = 0; j < 4; ++j) vf[(s + 1) & 1][j] = ld_vfrag_tr(vs, vbase, VR, sub * 64 + 16 * (s + 1), j * 32);
          }
          __builtin_amdgcn_sched_barrier(0); __builtin_amdgcn_s_setprio(1);
#pragma unroll
          for (int j = 0; j < 4; ++j) O[j] = mfma32(vf[s & 1][j], pf[s], O[j]);
        __builtin_amdgcn_s_setprio(0);
}
      }
      if (resc) {
#pragma unroll
        for (int j = 0; j < 4; ++j) scale16(O[j], alpha);
      }
    }
    if (kt + 1 < 32) put_stage(smem + ((kt + 1) & 1) * STG);
    else if (has_next) put_stage(smem);
    __syncthreads();
    if (kt + 2 < 32) get_stage(kt + 2);
    else if (kt == 30 && has_next) { gk += (nh - h) * 128; gv += (nh - h) * 128; get_stage(0); }
  }
  const float lt = l + shx(l, 32, lane);
  const float inv = 1.f / lt;
  float* xch = (float*)(smem + STG);
  if (map == 1) {
#pragma unroll
    for (int j = 0; j < 4; ++j)
#pragma unroll
      for (int i = 0; i < 16; ++i) xch[(rg * 64 + j * 16 + i) * 64 + lane] = O[j][i] * inv;
  }
  __syncthreads();
  if (map == 0) {
    const float lam = ((const float*)(p.ws + TB_LAM))[li];
    const int layer = 2 * li + 1;
    const float linit = 0.8f - 0.6f * expf(-0.3f * (float)layer);
    float ss = 0.f;
#pragma unroll
    for (int j = 0; j < 4; ++j)
#pragma unroll
      for (int i = 0; i < 16; ++i) {
        float v = O[j][i] * inv - lam * xch[(rg * 64 + j * 16 + i) * 64 + lane];
        O[j][i] = v; ss += v * v;
      }
    ss += shx(ss, 32, lane);
    const float rinv = rsqrtf(ss * (1.f / 128.f) + EPS) * (1.f - linit);
    const float* sub = p.c_subln + li * 128;
    u16* op = o + (size_t)qrow * 1024 + h * 128 + 4 * hh;
#pragma unroll
    for (int j = 0; j < 4; ++j)
#pragma unroll
      for (int i4 = 0; i4 < 4; ++i4) {
        const int dv = j * 32 + 8 * i4 + 4 * hh;
        const f32x4 g4 = *(const f32x4*)(sub + dv);
        f32x4 v = {O[j][4 * i4] * g4[0], O[j][4 * i4 + 1] * g4[1], O[j][4 * i4 + 2] * g4[2], O[j][4 * i4 + 3] * g4[3]};
        st_bf4(op + j * 32 + 8 * i4, v, rinv);
      }
  }
}

#define XB_TMO      128
#define XB_XCNT(j)  (256  + 64 * (j))
#define XB_XSUB(j)  (1280 + 64 * (j))
#define XB_XGEN(j)  (2304 + 64 * (j))
#define XB_TOP      3328
#define XB_TOPGEN   3392
#define XCD_BAR_WORDS 3456
#define XB_SPIN_CAP (1u << 18)
DI unsigned xb_ld(unsigned* p)              { return __hip_atomic_load(p, __ATOMIC_RELAXED, __HIP_MEMORY_SCOPE_AGENT); }
DI unsigned xb_add(unsigned* p, unsigned v) { return __hip_atomic_fetch_add(p, v, __ATOMIC_RELAXED, __HIP_MEMORY_SCOPE_AGENT); }
DI unsigned xb_xcc_id() { return (unsigned)__builtin_amdgcn_s_getreg((3 << 11) | 20) & 0xFu; }
#define XB_SPIN(cond, bar) do { unsigned _sp = 0; while (cond) { __builtin_amdgcn_s_sleep(1); \
    if ((++_sp & 255u) == 0u) { if (xb_ld(&(bar)[XB_TMO])) break; if (_sp > XB_SPIN_CAP) { atomicAdd(&(bar)[XB_TMO], 1u); break; } } } } while (0)
struct XcdBarrier { unsigned* bar; unsigned x; volatile LAS unsigned* st; };
DI XcdBarrier xcd_barrier_post(unsigned* bar, volatile LAS unsigned* st) {
  XcdBarrier b; b.bar = bar; b.x = xb_xcc_id(); b.st = st;
  if (threadIdx.x == 0) (void)xb_add(&bar[XB_XCNT(b.x)], 1u);
  return b;
}
DI void xcd_barrier_complete(unsigned* bar, unsigned x, unsigned& nloc, unsigned& nx) {
  const unsigned G = gridDim.x * gridDim.y * gridDim.z;
  unsigned sum, cnt, mine, sp = 0u;
  for (;;) {
    sum = 0u; cnt = 0u; mine = 0u;
#pragma unroll
    for (unsigned j = 0; j < 16; ++j) { const unsigned c = xb_ld(&bar[XB_XCNT(j)]); sum += c; cnt += (c > 0u) ? 1u : 0u; mine = (j == x) ? c : mine; }
    if (sum == G) break;
    __builtin_amdgcn_s_sleep(1);
    if ((++sp & 255u) == 0u) { if (xb_ld(&bar[XB_TMO])) break; if (sp > XB_SPIN_CAP) { atomicAdd(&bar[XB_TMO], 1u); break; } }
  }
  nloc = mine > 0u ? mine : 1u; nx = cnt > 0u ? cnt : 1u;
}
DI void xcd_barrier(const XcdBarrier& b) {
  asm volatile("s_waitcnt vmcnt(0)" ::: "memory");
  __syncthreads();
  if (threadIdx.x == 0) {
    size_t zb = 0; asm volatile("" : "+s"(zb));
    unsigned* bar = b.bar + zb;
    __builtin_amdgcn_s_waitcnt(0);
    unsigned nloc = b.st[0], nx = b.st[1];
    if (nloc == 0u) { xcd_barrier_complete(bar, b.x, nloc, nx); b.st[0] = nloc; b.st[1] = nx; }
    const unsigned old = xb_add(&bar[XB_XSUB(b.x)], 1u);
    const unsigned gen = old / nloc;
    if (old + 1u == (gen + 1u) * nloc) {
      __builtin_amdgcn_fence(__ATOMIC_RELEASE, "agent");
      asm volatile("s_waitcnt vmcnt(0)" ::: "memory");
      const unsigned og = xb_add(&bar[XB_TOP], 1u);
      const unsigned tg = og / nx;
      if (og + 1u == (tg + 1u) * nx) xb_add(&bar[XB_TOPGEN], 1u);
      else XB_SPIN(xb_ld(&bar[XB_TOPGEN]) == tg, bar);
      __builtin_amdgcn_fence(__ATOMIC_ACQUIRE, "agent");
      xb_add(&bar[XB_XGEN(b.x)], 1u);
      asm volatile("s_waitcnt vmcnt(0)" ::: "memory");
    } else {
      XB_SPIN(xb_ld(&bar[XB_XGEN(b.x)]) == gen, bar);
      __builtin_amdgcn_fence(__ATOMIC_ACQUIRE, "agent");
      asm volatile("s_waitcnt vmcnt(0)" ::: "memory");
    }
  }
  __syncthreads();
}

#define LAUNDER(q)  Params q = p; { size_t zoff = 0; asm volatile("" : "+s"(zoff)); q.ws = p.ws + zoff; q.xres = p.xres + zoff; q.x = p.x + zoff; }
#define PH_BEGIN(n) if (ph_lo <= (n) && (n) < ph_hi) { LAUNDER(q); char* ws = q.ws; (void)ws;
#define PH_END(n)   if ((n) + 1 < ph_hi) { xcd_barrier(xb); } }

__global__ void __launch_bounds__(512) mega(Params p, int ph_lo, int ph_hi) {
  extern __shared__ __attribute__((aligned(16))) unsigned char lds_raw[];
  LAS unsigned char* lds = (LAS unsigned char*)lds_raw;
  char* smem = (char*)lds_raw;
  const int nx = gridDim.x >> 3, xcd = blockIdx.x & 7, jx = blockIdx.x >> 3;
  volatile LAS unsigned* bst = (volatile LAS unsigned*)(lds + SM_BARST);
  if (threadIdx.x < 2) bst[threadIdx.x] = 0u;
  __syncthreads();
  const XcdBarrier xb = xcd_barrier_post((unsigned*)(p.ws + TB_BAR), bst);

  if (ph_lo < 0) cg::this_grid().sync();
  PH_BEGIN(0) phase_prep(q, smem); PH_END(0)

#pragma unroll 1
  for (int L = 0; L < 4; ++L) {
    const int pb = 1 + 8 * L, li = L >> 1;
    const bool even = (L & 1) == 0;
    if (even) {
      PH_BEGIN(pb + 1)
        run_gemm<EPI_ABIN>(lds, (const u16*)(ws + B_XR), (const u16*)(ws + W_ABIN) + (size_t)li * 2304 * 1024, 2304, 1024, q, nullptr, (const float*)(ws + TB_SSA), nullptr);
      PH_END(pb + 1)
      PH_BEGIN(pb + 2)
        run_gemm<EPI_UQ>(lds, (const u16*)(ws + B_BIG + E_CQ), (const u16*)(ws + W_UQ) + (size_t)li * 768 * 384, 768, 384, q, nullptr, nullptr, nullptr);
        run_gemm<EPI_UKV>(lds, (const u16*)(ws + B_BIG + E_CKV), (const u16*)(ws + W_UKV) + (size_t)li * 1024 * 256, 1024, 256, q, nullptr, nullptr, nullptr);
      PH_END(pb + 2)
      PH_BEGIN(pb + 3)
        if (jx < nx) {
          const int half = get_tid() >> 8;
          char* sm = smem + half * ATT_HALF;
#pragma unroll 1
          for (int u = jx; u < 128; u += nx) attn_mla_unit(q, xcd, u >> 4, u & 15, smem, u != jx, (u + nx) >> 4, u + nx < 128);
#pragma unroll 1
          for (int up = jx; up < 128; up += nx) { const int u = 2 * up + half; attn_na_unit(q, li, xcd, u >> 2, u & 3, sm); }
        }
      PH_END(pb + 3)
    } else {
      PH_BEGIN(pb + 1)
        run_gemm<EPI_CIN>(lds, (const u16*)(ws + B_XR), (const u16*)(ws + W_CIN) + (size_t)li * 3072 * 1024, 3072, 1024, q, nullptr, (const float*)(ws + TB_SSA), nullptr);
      PH_END(pb + 1)
      PH_BEGIN(pb + 3)
        if (jx < nx) {
          const int half = get_tid() >> 8;
          char* sm = smem + half * ATT_HALF;
#pragma unroll 1
          for (int u = jx; u < 256; u += nx) attn_diff_unit(q, li, xcd, u >> 5, u & 31, smem, u != jx, (u + nx) >> 5, u + nx < 256);
        }
      PH_END(pb + 3)
    }
    PH_BEGIN(pb + 4)
      run_gemm<EPI_RESID>(lds, (const u16*)(ws + B_H), (const u16*)(ws + (even ? W_ABOUT : W_COUT)) + (size_t)li * 1024 * 1024, 1024, 1024, q, (L == 0) ? q.x : nullptr, nullptr, (float*)(ws + TB_SSM));
    PH_END(pb + 4)
    PH_BEGIN(pb + 6)
      run_gemm<EPI_RELU2>(lds, (const u16*)(ws + B_XR), (const u16*)(ws + W_W1) + (size_t)L * 4096 * 1024, 4096, 1024, q, nullptr, (const float*)(ws + TB_SSM), nullptr);
    PH_END(pb + 6)
    PH_BEGIN(pb + 7)
      run_gemm<EPI_RESID>(lds, (const u16*)(ws + B_BIG), (const u16*)(ws + W_W2) + (size_t)L * 1024 * 4096, 1024, 4096, q, nullptr, nullptr, (float*)(ws + TB_SSA));
    PH_END(pb + 7)
  }

  PH_BEGIN(NPH - 1) phase_norm<true, true>(ws + B_XR, q.final_norm, nullptr, q.xres); PH_END(NPH - 1)
}

extern "C" void kernel_launch(void* const* d_in, const int* in_sizes, int n_in, void* d_out, int out_size,
                              void* d_ws, size_t ws_size, hipStream_t stream) {
  if (ws_size < WS_NEED) { fprintf(stderr, "workspace too small: %zu < %zu\n", ws_size, WS_NEED); return; }
  Params p{};
  p.x = (const float*)d_in[0]; p.norm_attn = (const float*)d_in[1]; p.norm_mlp = (const float*)d_in[2];
  p.ab_w_in = (const float*)d_in[3]; p.ab_q_norm = (const float*)d_in[4]; p.ab_w_uq = (const float*)d_in[5];
  p.ab_kv_norm = (const float*)d_in[6]; p.ab_w_ukv = (const float*)d_in[7]; p.ab_rpb = (const float*)d_in[8];
  p.ab_w_out = (const float*)d_in[9]; p.c_w_in = (const float*)d_in[10]; p.lq1 = (const float*)d_in[11];
  p.lk1 = (const float*)d_in[12]; p.lq2 = (const float*)d_in[13]; p.lk2 = (const float*)d_in[14];
  p.c_subln = (const float*)d_in[15]; p.c_w_out = (const float*)d_in[16]; p.t5 = (const float*)d_in[17];
  p.mlp_w1 = (const float*)d_in[18]; p.mlp_w2 = (const float*)d_in[19]; p.final_norm = (const float*)d_in[20];
  p.xres = (float*)d_out; p.ws = (char*)d_ws;

  static int grid_blocks = 0;
  if (!grid_blocks) {
    int dev = 0, cus = 0, per_cu = 0;
    (void)hipGetDevice(&dev);
    (void)hipDeviceGetAttribute(&cus, hipDeviceAttributeMultiprocessorCount, dev);
    if (hipFuncSetAttribute((const void*)mega, hipFuncAttributeMaxDynamicSharedMemorySize, SMEM_BYTES) != hipSuccess) { fprintf(stderr, "hipFuncSetAttribute failed\n"); grid_blocks = -1; return; }
    (void)hipOccupancyMaxActiveBlocksPerMultiprocessor(&per_cu, mega, NTHR, SMEM_BYTES);
    (void)hipGetLastError();
    grid_blocks = cus;
  }
  if (grid_blocks < 0) return;
#if MULTI_LAUNCH
  for (int ph = 0; ph < NPH; ++ph) {
    if (ph >= 1 && ph < NPH - 1 && ((ph - 1) & 7) == 2 && ((((ph - 1) >> 3) & 1) == 1)) continue;
    hipLaunchKernelGGL(mega, dim3(grid_blocks), dim3(NTHR), SMEM_BYTES, stream, p, ph, ph + 1);
  }
#else
  (void)hipMemsetAsync((char*)d_ws + TB_BAR, 0, 16384, stream);
  int lo = 0, hi = NPH;
  void* args[] = {&p, &lo, &hi};
  hipError_t e = hipLaunchCooperativeKernel((void*)mega, dim3(grid_blocks), dim3(NTHR), args, SMEM_BYTES, stream);
  if (e != hipSuccess) fprintf(stderr, "cooperative launch failed: %s (grid %d)\n", hipGetErrorString(e), grid_blocks);
#endif
}
```

```cpp
#include <hip/hip_runtime.h>
#include <hip/hip_cooperative_groups.h>
#include <cstdio>
namespace cg = cooperative_groups;

typedef unsigned short u16;
using bf16x8 = __attribute__((ext_vector_type(8))) short;
using s16x4  = __attribute__((ext_vector_type(4))) short;
using f32x4  = __attribute__((ext_vector_type(4))) float;
using f32x16 = __attribute__((ext_vector_type(16))) float;
using u32x4  = __attribute__((ext_vector_type(4))) unsigned;
using u32x2  = __attribute__((ext_vector_type(2))) unsigned;
typedef __bf16 bf2_t __attribute__((ext_vector_type(2)));
typedef float  fl2_t __attribute__((ext_vector_type(2)));
#define DI __device__ __forceinline__

#ifndef MULTI_LAUNCH
#define MULTI_LAUNCH 0
#endif

constexpr int T_ = 32768;
constexpr int S_ = 4096;
constexpr float LOG2E = 1.4426950408889634f;
constexpr float EPS = 1e-6f;
constexpr int NPH = 34;
constexpr int NTHR = 512;

constexpr size_t W_ABIN  = 0;
constexpr size_t W_UQ    = W_ABIN  + 2ull * 2304 * 1024 * 2;
constexpr size_t W_UKV   = W_UQ    + 2ull * 768 * 384 * 2;
constexpr size_t W_ABOUT = W_UKV   + 2ull * 1024 * 256 * 2;
constexpr size_t W_CIN   = W_ABOUT + 2ull * 1024 * 1024 * 2;
constexpr size_t W_COUT  = W_CIN   + 2ull * 3072 * 1024 * 2;
constexpr size_t W_W1    = W_COUT  + 2ull * 1024 * 1024 * 2;
constexpr size_t W_W2    = W_W1    + 4ull * 4096 * 1024 * 2;
constexpr size_t TB_COS  = W_W2    + 4ull * 4096 * 1024 * 2;
constexpr size_t TB_SIN  = TB_COS  + 4096ull * 16 * 4;
constexpr size_t TB_T5   = TB_SIN  + 4096ull * 16 * 4;
constexpr size_t TB_LAM  = TB_T5   + 8ull * 512 * 4;
constexpr size_t TB_SSA  = TB_LAM  + 256;
constexpr size_t TB_SSM  = TB_SSA  + (size_t)T_ * 16 * 4;
constexpr size_t TB_BAR  = TB_SSM  + (size_t)T_ * 16 * 4;
constexpr size_t B_H     = TB_BAR  + 16384;
constexpr size_t B_BIG   = B_H     + (size_t)T_ * 1024 * 2;
constexpr size_t E_CQ    = 0;
constexpr size_t E_CKV   = E_CQ    + (size_t)T_ * 384 * 2;
constexpr size_t E_KPE   = E_CKV   + (size_t)T_ * 256 * 2;
constexpr size_t E_QNA   = E_KPE   + (size_t)T_ * 32 * 2;
constexpr size_t E_KNA   = E_QNA   + (size_t)T_ * 512 * 2;
constexpr size_t E_VNAT  = E_KNA   + (size_t)T_ * 512 * 2;
constexpr size_t E_QMLA  = E_VNAT  + (size_t)T_ * 512 * 2;
constexpr size_t E_KNOPE = E_QMLA  + (size_t)T_ * 768 * 2;
constexpr size_t E_VMLAT = E_KNOPE + (size_t)T_ * 512 * 2;
constexpr size_t E_END   = E_VMLAT + (size_t)T_ * 512 * 2;
static_assert(E_END <= (size_t)T_ * 4096 * 2, "even buffers exceed BIG");
constexpr size_t O_QD    = 0;
constexpr size_t O_KD    = O_QD + (size_t)T_ * 1024 * 2;
constexpr size_t O_VDT   = O_KD + (size_t)T_ * 1024 * 2;
constexpr size_t B_XR    = B_BIG + (size_t)T_ * 4096 * 2;
constexpr size_t WS_NEED = B_XR + (size_t)T_ * 1024 * 2;

struct Params {
  const float* x; const float* norm_attn; const float* norm_mlp; const float* ab_w_in; const float* ab_q_norm;
  const float* ab_w_uq; const float* ab_kv_norm; const float* ab_w_ukv; const float* ab_rpb; const float* ab_w_out;
  const float* c_w_in; const float* lq1; const float* lk1; const float* lq2; const float* lk2; const float* c_subln;
  const float* c_w_out; const float* t5; const float* mlp_w1; const float* mlp_w2; const float* final_norm;
  float* xres; char* ws;
};

DI unsigned pack2(float a, float b) {
  fl2_t f = {a, b};
  bf2_t r = __builtin_convertvector(f, bf2_t);
  return __builtin_bit_cast(unsigned, r);
}
DI u16 f2bf(float x) { unsigned u = __float_as_uint(x); u += 0x7fffu + ((u >> 16) & 1u); return (u16)(u >> 16); }
DI float bf2f(unsigned v) { return __uint_as_float(v << 16); }
DI void st_bf4(u16* p, f32x4 v, float sc) {
  u32x2 u; u.x = pack2(v[0] * sc, v[1] * sc); u.y = pack2(v[2] * sc, v[3] * sc);
  *(u32x2*)p = u;
}
DI void st_bf8(u16* p, f32x4 a, f32x4 b, float sc) {
  u32x4 u; u.x = pack2(a[0] * sc, a[1] * sc); u.y = pack2(a[2] * sc, a[3] * sc); u.z = pack2(b[0] * sc, b[1] * sc); u.w = pack2(b[2] * sc, b[3] * sc);
  *(u32x4*)p = u;
}
DI void st_T(u16* p, f32x4 v, float sc) {
#pragma unroll
  for (int i = 0; i < 4; ++i) p[(size_t)i * S_] = f2bf(v[i] * sc);
}
DI int get_tid() { int t = threadIdx.x; asm volatile("" : "+v"(t)); return t; }
DI float shx(float v, int mask, int lane) {
  return __int_as_float(__builtin_amdgcn_ds_bpermute((lane ^ mask) << 2, __float_as_int(v)));
}
DI float wave_sum(float v, int lane) {
#pragma unroll
  for (int o = 32; o > 0; o >>= 1) v += shx(v, o, lane);
  return v;
}
DI f32x16 mfma32(bf16x8 a, bf16x8 b, f32x16 c) { return __builtin_amdgcn_mfma_f32_32x32x16_bf16(a, b, c, 0, 0, 0); }
DI f32x4 mfma16(bf16x8 a, bf16x8 b, f32x4 c) { return __builtin_amdgcn_mfma_f32_16x16x32_bf16(a, b, c, 0, 0, 0); }
DI bf16x8 pack8(const f32x16& s, int o) {
  u32x4 u;
  u.x = pack2(s[o + 0], s[o + 1]); u.y = pack2(s[o + 2], s[o + 3]);
  u.z = pack2(s[o + 4], s[o + 5]); u.w = pack2(s[o + 6], s[o + 7]);
  return __builtin_bit_cast(bf16x8, u);
}

DI void prep_wt(const float* __restrict__ src, u16* __restrict__ dst, int K, int N, int Npad,
                const float* __restrict__ gain, float* tile) {
  const int tid = get_tid();
  const int tk = K / 64, tn = Npad / 64, nt4 = tk * tn;
  constexpr int TS = 64 * 65;
  for (int t0 = blockIdx.x; t0 < nt4; t0 += 4 * gridDim.x) {
    f32x4 v[4][2];
#pragma unroll
    for (int j = 0; j < 4; ++j) {
      const int t = t0 + j * gridDim.x;
      const int kt = t % tk, nt = t / tk;
#pragma unroll
      for (int i = 0; i < 2; ++i) {
        const int e = tid + NTHR * i; const int kk = e >> 4, n4 = (e & 15) * 4; const int n = nt * 64 + n4;
        v[j][i] = (f32x4){0.f, 0.f, 0.f, 0.f};
        if (t < nt4 && n < N) {
          v[j][i] = *(const f32x4*)(src + (size_t)(kt * 64 + kk) * N + n);
          if (gain) v[j][i] *= gain[kt * 64 + kk];
        }
      }
    }
    __syncthreads();
#pragma unroll
    for (int j = 0; j < 4; ++j)
#pragma unroll
      for (int i = 0; i < 2; ++i) {
        const int e = tid + NTHR * i; const int kk = e >> 4, n4 = (e & 15) * 4;
        float* tp = tile + j * TS + kk * 65 + n4;
        tp[0] = v[j][i][0]; tp[1] = v[j][i][1]; tp[2] = v[j][i][2]; tp[3] = v[j][i][3];
      }
    __syncthreads();
#pragma unroll
    for (int j = 0; j < 4; ++j) {
      const int t = t0 + j * gridDim.x;
      if (t < nt4) {
        const int kt = t % tk, nt = t / tk;
        const int nn = tid >> 3, k8 = (tid & 7) * 8;
        const float* tp = tile + j * TS + k8 * 65 + nn;
        u32x4 u;
        u.x = pack2(tp[0 * 65], tp[1 * 65]); u.y = pack2(tp[2 * 65], tp[3 * 65]);
        u.z = pack2(tp[4 * 65], tp[5 * 65]); u.w = pack2(tp[6 * 65], tp[7 * 65]);
        *(u32x4*)(dst + (size_t)(nt * 64 + nn) * K + kt * 64 + k8) = u;
      }
    }
  }
}

DI int t5_bucket(int rel) {
  int ret = rel > 0 ? 16 : 0;
  int n = rel < 0 ? -rel : rel;
  int b;
  if (n < 8) b = n;
  else { int lg = 31 - __clz(n * n); b = 8 + lg - 6; if (b > 15) b = 15; }
  return ret + b;
}

DI void phase_prep(const Params& p, char* smem) {
  float* tile = (float*)smem;
  char* ws = p.ws;
  for (int i = 0; i < 2; ++i) {
    prep_wt(p.ab_w_in + (size_t)i * 1024 * 2208, (u16*)(ws + W_ABIN) + (size_t)i * 2304 * 1024, 1024, 2208, 2304, p.norm_attn + (2 * i) * 1024, tile);
    prep_wt(p.ab_w_uq + (size_t)i * 384 * 768, (u16*)(ws + W_UQ) + (size_t)i * 768 * 384, 384, 768, 768, p.ab_q_norm + i * 384, tile);
    prep_wt(p.ab_w_ukv + (size_t)i * 256 * 1024, (u16*)(ws + W_UKV) + (size_t)i * 1024 * 256, 256, 1024, 1024, p.ab_kv_norm + i * 256, tile);
    prep_wt(p.ab_w_out + (size_t)i * 1024 * 1024, (u16*)(ws + W_ABOUT) + (size_t)i * 1024 * 1024, 1024, 1024, 1024, nullptr, tile);
    prep_wt(p.c_w_in + (size_t)i * 1024 * 3072, (u16*)(ws + W_CIN) + (size_t)i * 3072 * 1024, 1024, 3072, 3072, p.norm_attn + (2 * i + 1) * 1024, tile);
    prep_wt(p.c_w_out + (size_t)i * 1024 * 1024, (u16*)(ws + W_COUT) + (size_t)i * 1024 * 1024, 1024, 1024, 1024, nullptr, tile);
  }
  for (int i = 0; i < 4; ++i) {
    prep_wt(p.mlp_w1 + (size_t)i * 1024 * 4096, (u16*)(ws + W_W1) + (size_t)i * 4096 * 1024, 1024, 4096, 4096, p.norm_mlp + i * 1024, tile);
    prep_wt(p.mlp_w2 + (size_t)i * 4096 * 1024, (u16*)(ws + W_W2) + (size_t)i * 1024 * 4096, 4096, 1024, 1024, nullptr, tile);
  }
  {
    const int t0 = get_tid(); const int wave = t0 >> 6, lane = t0 & 63;
    u16* xb = (u16*)(ws + B_XR); float* ssa = (float*)(ws + TB_SSA);
    for (int row = blockIdx.x * 8 + wave; row < T_; row += gridDim.x * 8) {
      const f32x4* xr = (const f32x4*)(p.x + (size_t)row * 1024);
      float ss = 0.f;
#pragma unroll
      for (int i = 0; i < 2; ++i) {
        const f32x4 a = xr[2 * lane + 128 * i], b = xr[2 * lane + 128 * i + 1];
        ss += a[0] * a[0] + a[1] * a[1] + a[2] * a[2] + a[3] * a[3] + b[0] * b[0] + b[1] * b[1] + b[2] * b[2] + b[3] * b[3];
        st_bf8(xb + (size_t)row * 1024 + 8 * lane + 512 * i, a, b, 1.f);
      }
      ss = wave_sum(ss, lane);
      if (lane < 16) ssa[(size_t)row * 16 + lane] = (lane == 0) ? ss : 0.f;
    }
  }
  const int gt = blockIdx.x * NTHR + get_tid(), gn = gridDim.x * NTHR;
  float* tcos = (float*)(ws + TB_COS); float* tsin = (float*)(ws + TB_SIN);
  for (int idx = gt; idx < 4096 * 16; idx += gn) {
    int pos = idx >> 4, j = idx & 15;
    float inv = exp2f(-(float)j * (13.287712379549449f / 16.0f));
    float ang = (float)pos * inv;
    tcos[idx] = cosf(ang);
    tsin[idx] = sinf(ang);
  }
  float* t5t = (float*)(ws + TB_T5);
  for (int idx = gt; idx < 8 * 512; idx += gn) {
    int h = idx >> 9, e = idx & 511; int rel = e - 255; if (rel > 255) rel = 255;
    t5t[idx] = p.t5[t5_bucket(rel) * 8 + h] * LOG2E;
  }
  if (gt < 2) {
    float s1 = 0.f, s2 = 0.f;
    for (int d = 0; d < 64; ++d) { s1 += p.lq1[gt * 64 + d] * p.lk1[gt * 64 + d]; s2 += p.lq2[gt * 64 + d] * p.lk2[gt * 64 + d]; }
    int layer = 2 * gt + 1;
    float li = 0.8f - 0.6f * expf(-0.3f * (float)layer);
    ((float*)(ws + TB_LAM))[gt] = expf(s1) - expf(s2) + li;
  }
}

template <bool FINAL, bool IN_BF16>
DI void phase_norm(const void* __restrict__ xin, const float* __restrict__ g, u16* __restrict__ h, float* __restrict__ outf) {
  const int tid = get_tid();
  const int wave = tid >> 6, lane = tid & 63;
  for (int row = blockIdx.x * 8 + wave; row < T_; row += gridDim.x * 8) {
    f32x4 v[4]; float ss = 0.f;
    if (IN_BF16) {
      const u32x4* xr = (const u32x4*)((const u16*)xin + (size_t)row * 1024);
#pragma unroll
      for (int i = 0; i < 2; ++i) {
        const u32x4 u = xr[lane + 64 * i];
        v[2 * i]     = (f32x4){bf2f(u.x & 0xffffu), bf2f(u.x >> 16), bf2f(u.y & 0xffffu), bf2f(u.y >> 16)};
        v[2 * i + 1] = (f32x4){bf2f(u.z & 0xffffu), bf2f(u.z >> 16), bf2f(u.w & 0xffffu), bf2f(u.w >> 16)};
      }
    } else {
      const f32x4* xr = (const f32x4*)((const float*)xin + (size_t)row * 1024);
#pragma unroll
      for (int i = 0; i < 2; ++i) { v[2 * i] = xr[2 * lane + 128 * i]; v[2 * i + 1] = xr[2 * lane + 128 * i + 1]; }
    }
#pragma unroll
    for (int i = 0; i < 4; ++i) ss += v[i][0] * v[i][0] + v[i][1] * v[i][1] + v[i][2] * v[i][2] + v[i][3] * v[i][3];
    ss = wave_sum(ss, lane);
    const float rinv = rsqrtf(ss * (1.f / 1024.f) + EPS);
#pragma unroll
    for (int i = 0; i < 2; ++i) {
      const f32x4 g0 = ((const f32x4*)g)[2 * lane + 128 * i], g1 = ((const f32x4*)g)[2 * lane + 128 * i + 1];
      const f32x4 a = v[2 * i] * g0 * rinv, b = v[2 * i + 1] * g1 * rinv;
      if (FINAL) {
        f32x4* op = (f32x4*)(outf + (size_t)row * 1024);
        op[2 * lane + 128 * i] = a; op[2 * lane + 128 * i + 1] = b;
      } else {
        st_bf8(h + (size_t)row * 1024 + 8 * lane + 512 * i, a, b, 1.f);
      }
    }
  }
}

constexpr int SM_ATT_V = 17408;
constexpr int SM_ATT_TAB = 17408 + 64 * 320;
constexpr int STAGE_LDS = 131072;
constexpr int SM_RINVTAB = STAGE_LDS;
constexpr int ATT_LDS = 2 * (128 * 272 + 128 * 320) + 2048;
constexpr int SM_BARST = ATT_LDS;
constexpr int SMEM_BYTES = ATT_LDS + 16;
static_assert(ATT_LDS >= STAGE_LDS + 4096, "LDS map");
constexpr int ATT_HALF = 45056;
#define LAS __attribute__((address_space(3)))

namespace pg8 {
constexpr int BM = 256, BK = 64, HALF = 128, HTB = HALF * BK * 2, NXCD = 8, WGM = 8;
DI int lds_byte(int r, int c) { const int st = (r >> 4) * 2 + (c >> 5), rr = r & 15, cc = c & 31, ob = rr * 64 + cc * 2; return st * 1024 + (ob ^ (((ob >> 9) & 1) << 5)); }
DI void stage_rc(int b, int& R, int& C) { const int st = b / 1024, sb = b % 1024, swz = sb ^ (((sb >> 9) & 1) << 5); R = (st >> 1) * 16 + swz / 64; C = (st & 1) * 32 + (swz % 64) / 2; }
DI int perm32(int rho) { const int n = rho >> 4, i = rho & 15; return 8 * (i >> 2) + 4 * n + (i & 3); }
struct Unit { int pm, pn; };
struct Gemm { const u16* A; const u16* Bt; int M, N, K; };
struct StaticOrder {
  int nM, nN, nwg, G, c, rev, revn;
  DI void init(int M, int N, int G_, int c_) { nM = M / BM; nN = N / BM; nwg = nM * nN; G = G_; c = c_; rev = 0; revn = 0; }
  DI bool next(int i, Unit& u) const {
    if ((long)i * G + c >= nwg) return false;
    const int ii = (rev && (nwg % G) == 0) ? (nwg / G - 1 - i) : i;
    const long L = (long)ii * G + c;
    int wgid = (int)L; { const int q = nwg / NXCD, r = nwg % NXCD, xcd = wgid % NXCD, off = wgid / NXCD; wgid = (xcd < r ? xcd * (q + 1) : r * (q + 1) + (xcd - r) * q) + off; }
    const int nig = WGM * nN, gid = wgid / nig, fm = gid * WGM, gsz = (nM - fm) < WGM ? (nM - fm) : WGM;
    u.pm = fm + ((wgid % nig) % gsz); u.pn = (wgid % nig) / gsz; if (revn) u.pn = nN - 1 - u.pn; return true;
  }
};

template <class Epi, class Sched>
DI void gemm_phase(LAS unsigned char* lds, const Gemm g, const Sched& S, const Epi& E) {
  const int tid = get_tid(), wid = __builtin_amdgcn_readfirstlane(tid >> 6), lane = tid & 63, wr = wid >> 2, wc = wid & 3, fr = lane & 15, fq = lane >> 4;
  const int K = g.K, nt = K / BK;
  unsigned voffA[2], voffB[2];
#pragma unroll
  for (int i = 0; i < 2; ++i) { int R, C; stage_rc(tid * 16 + i * 8192, R, C); const int Rb = Epi::PERM ? ((R & ~31) + perm32(R & 31)) : R;
    voffA[i] = (unsigned)(R * K + C) * 2u; voffB[i] = (unsigned)(Rb * K + C) * 2u; }
  const size_t kstep = (size_t)(BK * 2);
  const size_t hstep = (size_t)HALF * K * 2;
  const size_t tstep = 2 * hstep;
  const unsigned ldsw = (unsigned)wid * 1024u;
  const int aoff = lds_byte(wr * 64 + fr, fq * 8), boff = lds_byte(wc * 32 + fr, fq * 8);
#define PG8_SA(b, h) (((b) * 2 + (h)) * HTB)
#define PG8_SB(b, h) ((4 + (b) * 2 + (h)) * HTB)
#define PG8_STAGE(bufoff, gbase, voff) do { _Pragma("unroll") for (int _i = 0; _i < 2; ++_i) \
    __builtin_amdgcn_global_load_lds((const unsigned*)((const char*)(gbase) + (voff)[_i]), (LAS unsigned*)(lds + (bufoff) + ldsw + _i * 8192), 16, 0, 0); } while (0)
#define PG8_LDA(dst, b, h) do { _Pragma("unroll") for (int m = 0; m < 4; ++m) _Pragma("unroll") for (int k = 0; k < 2; ++k) dst[m][k] = *(const LAS bf16x8*)(lds + PG8_SA(b, h) + aoff + m * 2048 + k * 1024); } while (0)
#define PG8_LDB(dst, b, h) do { _Pragma("unroll") for (int n = 0; n < 2; ++n) _Pragma("unroll") for (int k = 0; k < 2; ++k) dst[n][k] = *(const LAS bf16x8*)(lds + PG8_SB(b, h) + boff + n * 2048 + k * 1024); } while (0)
#define PG8_MMA(ai, bj, At, Bt) do { __builtin_amdgcn_s_setprio(1); _Pragma("unroll") for (int m = 0; m < 4; ++m) _Pragma("unroll") for (int n = 0; n < 2; ++n) _Pragma("unroll") for (int k = 0; k < 2; ++k) \
    acc[ai][bj][m][n] = __builtin_amdgcn_mfma_f32_16x16x32_bf16(Bt[n][k], At[m][k], acc[ai][bj][m][n], 0, 0, 0); __builtin_amdgcn_s_setprio(0); } while (0)
#define PG8_WAIT_V(n) asm volatile("s_waitcnt vmcnt(" #n ")" ::: "memory")
#define PG8_WAIT_L(n) asm volatile("s_waitcnt lgkmcnt(" #n ")" ::: "memory")
#define PG8_BAR __builtin_amdgcn_s_barrier()
#define PG8_SCHED __builtin_amdgcn_sched_barrier(0)
  Unit cur, nxt; int ui = 0;
  if (!S.next(0, cur)) return;
  f32x4 acc[2][2][4][2];
#pragma unroll
  for (int a = 0; a < 2; ++a)
#pragma unroll
    for (int b = 0; b < 2; ++b)
#pragma unroll
      for (int m = 0; m < 4; ++m)
#pragma unroll
        for (int n = 0; n < 2; ++n) acc[a][b][m][n] = (f32x4){0.f, 0.f, 0.f, 0.f};
  bf16x8 At[4][2], B0[2][2], B1[2][2];
  const char* cA = (const char*)g.A + (size_t)cur.pm * tstep; const char* cB = (const char*)g.Bt + (size_t)cur.pn * tstep;
  PG8_STAGE(PG8_SB(0, 0), cB, voffB); PG8_STAGE(PG8_SA(0, 0), cA, voffA); PG8_STAGE(PG8_SB(0, 1), cB + hstep, voffB); PG8_STAGE(PG8_SA(0, 1), cA + hstep, voffA);
  if (wr == 1) PG8_BAR;
  PG8_WAIT_V(4); PG8_BAR;
  PG8_STAGE(PG8_SB(1, 0), cB + kstep, voffB); PG8_STAGE(PG8_SA(1, 0), cA + kstep, voffA); PG8_STAGE(PG8_SB(1, 1), cB + hstep + kstep, voffB);
  PG8_WAIT_V(6); PG8_BAR;
  for (;;) {
    const bool has_next = S.next(ui + 1, nxt);
    const char* nA = has_next ? (const char*)g.A + (size_t)nxt.pm * tstep : cA; const char* nB = has_next ? (const char*)g.Bt + (size_t)nxt.pn * tstep : cB;
#pragma unroll 1
    for (int t = 0; t < nt; t += 2) {
      const bool last = (t == nt - 2);
      const char* a1 = cA + (size_t)(t + 1) * kstep;
      const char* a2 = last ? nA : cA + (size_t)(t + 2) * kstep; const char* b2 = last ? nB : cB + (size_t)(t + 2) * kstep;
      const char* a3 = a2 + kstep; const char* b3 = b2 + kstep;
      PG8_LDB(B0, 0, 0); PG8_SCHED; PG8_LDA(At, 0, 0); PG8_STAGE(PG8_SA(1, 1), a1 + hstep, voffA);
      PG8_WAIT_L(8); PG8_BAR; PG8_WAIT_L(0); PG8_MMA(0, 0, At, B0); PG8_BAR; PG8_SCHED;
      PG8_LDB(B1, 0, 1); PG8_STAGE(PG8_SB(0, 0), b2, voffB);
      PG8_BAR; PG8_WAIT_L(0); PG8_MMA(0, 1, At, B1); PG8_BAR;
      PG8_LDA(At, 0, 1); PG8_STAGE(PG8_SA(0, 0), a2, voffA);
      PG8_BAR; PG8_WAIT_L(0); PG8_MMA(1, 0, At, B0); PG8_BAR; PG8_SCHED;
      PG8_STAGE(PG8_SB(0, 1), b2 + hstep, voffB);
      PG8_WAIT_V(6); PG8_BAR; PG8_MMA(1, 1, At, B1); PG8_BAR;
      PG8_LDB(B0, 1, 0); PG8_SCHED; PG8_LDA(At, 1, 0); PG8_STAGE(PG8_SA(0, 1), a2 + hstep, voffA);
      PG8_WAIT_L(8); PG8_BAR; PG8_WAIT_L(0); PG8_MMA(0, 0, At, B0); PG8_BAR; PG8_SCHED;
      PG8_LDB(B1, 1, 1); PG8_STAGE(PG8_SB(1, 0), b3, voffB);
      PG8_BAR; PG8_WAIT_L(0); PG8_MMA(0, 1, At, B1); PG8_BAR;
      PG8_LDA(At, 1, 1); PG8_STAGE(PG8_SA(1, 0), a3, voffA);
      PG8_BAR; PG8_WAIT_L(0); PG8_MMA(1, 0, At, B0); PG8_BAR; PG8_SCHED;
      PG8_STAGE(PG8_SB(1, 1), b3 + hstep, voffB);
      PG8_WAIT_V(6); PG8_BAR; PG8_MMA(1, 1, At, B1); PG8_BAR;
    }
    E(acc, cur, wr, wc, fr, fq);
    if (!has_next) break;
#pragma unroll
    for (int a = 0; a < 2; ++a)
#pragma unroll
      for (int b = 0; b < 2; ++b)
#pragma unroll
        for (int m = 0; m < 4; ++m)
#pragma unroll
          for (int n = 0; n < 2; ++n) acc[a][b][m][n] = (f32x4){0.f, 0.f, 0.f, 0.f};
    cur = nxt; cA = nA; cB = nB; ++ui;
  }
  PG8_WAIT_V(0);
  if (wr == 0) PG8_BAR;
  PG8_BAR;
#undef PG8_SA
#undef PG8_SB
#undef PG8_STAGE
#undef PG8_LDA
#undef PG8_LDB
#undef PG8_MMA
#undef PG8_WAIT_V
#undef PG8_WAIT_L
#undef PG8_BAR
#undef PG8_SCHED
}
}

DI void rope_perm(f32x4& a0, f32x4& a1, int fq, int lane, const float* tcos, const float* tsin, int pos) {
  f32x4 p0, p1;
#pragma unroll
  for (int e = 0; e < 4; ++e) { p0[e] = shx(a0[e], 32, lane); p1[e] = shx(a1[e], 32, lane); }
  const int jb = 8 * (fq & 1);
  const f32x4 c0 = *(const f32x4*)(tcos + pos * 16 + jb), c1 = *(const f32x4*)(tcos + pos * 16 + jb + 4);
  const f32x4 s0 = *(const f32x4*)(tsin + pos * 16 + jb), s1 = *(const f32x4*)(tsin + pos * 16 + jb + 4);
  if (fq < 2) { a0 = a0 * c0 - p0 * s0; a1 = a1 * c1 - p1 * s1; }
  else        { a0 = a0 * c0 + p0 * s0; a1 = a1 * c1 + p1 * s1; }
}
enum { EPI_ABIN = 0, EPI_UQ = 1, EPI_UKV = 2, EPI_CIN = 3, EPI_RESID = 4, EPI_RELU2 = 5 };

template <int EPI> struct Epi {
  static constexpr bool PERM = true, AFTER_DRAIN = false;
  char* big; const float* rsrc; float* rdst; const float* tcos; const float* tsin;
  const LAS float* rinv_tab;
  u16* xr; float* ss_out;
  mutable int round;
  DI void operator()(const f32x4 (&acc)[2][2][4][2], const pg8::Unit& u, int wr, int wc, int fr_, int fq_) const {
    const int t_ = get_tid();
    const int fr = t_ & 15, fq = (t_ >> 4) & 3;
    const int slot = round; round = round + 1;
#pragma unroll
    for (int ai = 0; ai < 2; ++ai)
#pragma unroll
      for (int m = 0; m < 4; ++m) {
        const int rl = ai * 128 + wr * 64 + m * 16 + fr;
        const int token = u.pm * 256 + rl;
        float rinv = 1.f;
        if (EPI != EPI_RESID) rinv = rinv_tab[slot * 256 + rl];
        float ssq = 0.f;
#pragma unroll
        for (int bj = 0; bj < 2; ++bj)
#pragma unroll
          for (int n = 0; n < 2; ++n) {
            const int fb = u.pn * 256 + bj * 128 + wc * 32 + n * 16;
            const int f = fb + 4 * fq;
            const f32x4 v = acc[ai][bj][m][n];
            if (EPI == EPI_ABIN) {
              if (n == 0) {
                const int gb = u.pn * 256 + bj * 128 + wc * 32; const int f8 = gb + 8 * fq;
                const f32x4 v1 = acc[ai][bj][m][1];
                if (gb < 384) st_bf8((u16*)(big + E_CQ) + (size_t)token * 384 + f8, v, v1, rinv);
                else if (gb < 640) st_bf8((u16*)(big + E_CKV) + (size_t)token * 256 + (f8 - 384), v, v1, rinv);
                else if (gb < 672) {
                  f32x4 a0 = v, a1 = v1;
                  rope_perm(a0, a1, fq, t_ & 63, tcos, tsin, token & (S_ - 1));
                  st_bf8((u16*)(big + E_KPE) + (size_t)token * 32 + 8 * fq, a0, a1, rinv);
                }
                else if (gb < 1184) st_bf8((u16*)(big + E_QNA) + (size_t)token * 512 + (f8 - 672), v, v1, rinv * (0.125f * LOG2E));
                else if (gb < 1696) st_bf8((u16*)(big + E_KNA) + (size_t)token * 512 + (f8 - 1184), v, v1, rinv);
                else if (gb < 2208) st_bf8((u16*)(big + E_VNAT) + (size_t)token * 512 + (f8 - 1696), v, v1, rinv);
              }
            } else if (EPI == EPI_UQ) {
              if (n == 0) {
                const float sc = rinv * (0.10206207261596575f * LOG2E);
                const int gb = u.pn * 256 + bj * 128 + wc * 32;
                const int hd = gb / 96; const int within = gb - hd * 96;
                f32x4 a0 = v, a1 = acc[ai][bj][m][1];
                if (within == 64) rope_perm(a0, a1, fq, t_ & 63, tcos, tsin, token & (S_ - 1));
                st_bf8((u16*)(big + E_QMLA) + (size_t)token * 768 + gb + 8 * fq, a0, a1, sc);
              }
            } else if (EPI == EPI_UKV) {
              if (n == 0) {
                const int gb = u.pn * 256 + bj * 128 + wc * 32;
                const int hd = gb >> 7, within = (gb & 127) + 8 * fq;
                const f32x4 v1 = acc[ai][bj][m][1];
                if (within < 64) st_bf8((u16*)(big + E_KNOPE) + (size_t)token * 512 + hd * 64 + within, v, v1, rinv);
                else st_bf8((u16*)(big + E_VMLAT) + (size_t)token * 512 + hd * 64 + (within - 64), v, v1, rinv);
              }
            } else if (EPI == EPI_CIN) {
              if (n == 0) {
                const int gb = u.pn * 256 + bj * 128 + wc * 32;
                const int f8 = gb + 8 * fq;
                const f32x4 v1 = acc[ai][bj][m][1];
                if (gb < 1024) st_bf8((u16*)(big + O_QD) + (size_t)token * 1024 + f8, v, v1, rinv * (0.125f * LOG2E));
                else if (gb < 2048) st_bf8((u16*)(big + O_KD) + (size_t)token * 1024 + (f8 - 1024), v, v1, rinv);
                else st_bf8((u16*)(big + O_VDT) + (size_t)token * 1024 + (f8 - 2048), v, v1, rinv);
              }
            } else if (EPI == EPI_RESID) {
              if (n == 0) {
                const int f8 = u.pn * 256 + bj * 128 + wc * 32 + 8 * fq;
                const f32x4 v1 = acc[ai][bj][m][1];
                f32x4 r0, r1;
                if (rsrc) {
                  r0 = *(const f32x4*)(rsrc + (size_t)token * 1024 + f8); r1 = *(const f32x4*)(rsrc + (size_t)token * 1024 + f8 + 4);
                } else {
                  const u32x4 xu = *(const u32x4*)(xr + (size_t)token * 1024 + f8);
                  r0 = (f32x4){bf2f(xu.x & 0xffffu), bf2f(xu.x >> 16), bf2f(xu.y & 0xffffu), bf2f(xu.y >> 16)};
                  r1 = (f32x4){bf2f(xu.z & 0xffffu), bf2f(xu.z >> 16), bf2f(xu.w & 0xffffu), bf2f(xu.w >> 16)};
                }
                r0 += v; r1 += v1;
                st_bf8(xr + (size_t)token * 1024 + f8, r0, r1, 1.f);
                ssq += r0[0] * r0[0] + r0[1] * r0[1] + r0[2] * r0[2] + r0[3] * r0[3] + r1[0] * r1[0] + r1[1] * r1[1] + r1[2] * r1[2] + r1[3] * r1[3];
              }
            } else {
              if (n == 0) {
                const f32x4 v1 = acc[ai][bj][m][1];
                u32x4 o4;
                { const float t0 = fmaxf(v[0], 0.f) * rinv, t1 = fmaxf(v[1], 0.f) * rinv, t2 = fmaxf(v[2], 0.f) * rinv, t3 = fmaxf(v[3], 0.f) * rinv;
                  o4.x = pack2(t0 * t0, t1 * t1); o4.y = pack2(t2 * t2, t3 * t3); }
                { const float t0 = fmaxf(v1[0], 0.f) * rinv, t1 = fmaxf(v1[1], 0.f) * rinv, t2 = fmaxf(v1[2], 0.f) * rinv, t3 = fmaxf(v1[3], 0.f) * rinv;
                  o4.z = pack2(t0 * t0, t1 * t1); o4.w = pack2(t2 * t2, t3 * t3); }
                *(u32x4*)((u16*)big + (size_t)token * 4096 + u.pn * 256 + bj * 128 + wc * 32 + 8 * fq) = o4;
              }
            }
          }
        if (EPI == EPI_RESID) {
          ssq += shx(ssq, 16, t_ & 63);
          ssq += shx(ssq, 32, t_ & 63);
          if (fq == 0) ss_out[(size_t)token * 16 + u.pn * 4 + wc] = ssq;
        }
      }
  }
};

DI void rinv_prepass(const u16* __restrict__ A, int K, const pg8::StaticOrder& S, LAS float* tab) {
  const int tid = get_tid();
  const int row = tid >> 1, half = tid & 1;
  pg8::Unit u;
  for (int i = 0; i < 4 && S.next(i, u); ++i) {
    const u16* pr = A + (size_t)(u.pm * 256 + row) * K + half * (K >> 1);
    float ss = 0.f;
    for (int c = 0; c < (K >> 1); c += 8) {
      u32x4 w = *(const u32x4*)(pr + c);
      float a;
      a = bf2f(w.x & 0xffffu); ss += a * a; a = bf2f(w.x >> 16); ss += a * a;
      a = bf2f(w.y & 0xffffu); ss += a * a; a = bf2f(w.y >> 16); ss += a * a;
      a = bf2f(w.z & 0xffffu); ss += a * a; a = bf2f(w.z >> 16); ss += a * a;
      a = bf2f(w.w & 0xffffu); ss += a * a; a = bf2f(w.w >> 16); ss += a * a;
    }
    ss += shx(ss, 1, tid & 63);
    if (!half) tab[i * 256 + row] = rsqrtf(ss / (float)K + EPS);
  }
  __syncthreads();
}

DI void norm_prepass(const float* __restrict__ ss, const pg8::StaticOrder& S, LAS float* tab) {
  const int tid = get_tid();
  const int row = tid >> 1, half = tid & 1;
  pg8::Unit u;
  for (int i = 0; i < 8 && S.next(i, u); ++i) {
    const f32x4* sp = (const f32x4*)(ss + (size_t)(u.pm * 256 + row) * 16 + half * 8);
    const f32x4 a = sp[0], b = sp[1];
    float t = a[0]; t += a[1]; t += a[2]; t += a[3]; t += b[0]; t += b[1]; t += b[2]; t += b[3];
    const float o = shx(t, 1, tid & 63);
    const float tot = half ? (o + t) : (t + o);
    if (!half) tab[i * 256 + row] = rsqrtf(tot * (1.f / 1024.f) + EPS);
  }
  __syncthreads();
}

template <int EPI>
DI void run_gemm(LAS unsigned char* lds, const u16* A, const u16* Bt, int N, int K, const Params& q, const float* rsrc,
                 const float* ss_in, float* ss_out) {
  pg8::Gemm g; g.A = A; g.Bt = Bt; g.M = T_; g.N = N; g.K = K;
  pg8::StaticOrder S; S.init(T_, N, gridDim.x, blockIdx.x);
  if (EPI == EPI_RESID && K == 4096) S.rev = 1;
  if (EPI == EPI_ABIN) S.revn = 1;
  Epi<EPI> E;
  E.big = q.ws + B_BIG; E.rsrc = rsrc; E.rdst = q.xres;
  E.tcos = (const float*)(q.ws + TB_COS); E.tsin = (const float*)(q.ws + TB_SIN);
  E.rinv_tab = (const LAS float*)(lds + SM_RINVTAB); E.round = 0;
  E.xr = (u16*)(q.ws + B_XR); E.ss_out = ss_out;
  if (EPI == EPI_UQ || EPI == EPI_UKV) rinv_prepass(A, K, S, (LAS float*)(lds + SM_RINVTAB));
  if (EPI == EPI_ABIN || EPI == EPI_CIN || EPI == EPI_RELU2) norm_prepass(ss_in, S, (LAS float*)(lds + SM_RINVTAB));
  pg8::gemm_phase(lds, g, S, E);
}

DI bool softmax_tile(f32x16& s0, f32x16& s1, float& m, float& l, float& alpha, bf16x8* pf, int lane, bool first, bool check) {
  if (first) {
    float mx = fmaxf(s0[0], s1[0]);
#pragma unroll
    for (int i = 1; i < 16; ++i) mx = fmaxf(mx, fmaxf(s0[i], s1[i]));
    mx = fmaxf(mx, shx(mx, 32, lane));
    m += mx;
#pragma unroll
    for (int i = 0; i < 16; ++i) { s0[i] -= mx; s1[i] -= mx; }
  }
  float sum = 0.f;
#pragma unroll
  for (int i = 0; i < 16; ++i) { s0[i] = __builtin_amdgcn_exp2f(s0[i]); sum += s0[i]; }
#pragma unroll
  for (int i = 0; i < 16; ++i) { s1[i] = __builtin_amdgcn_exp2f(s1[i]); sum += s1[i]; }
  l += sum;
  pf[0] = pack8(s0, 0); pf[1] = pack8(s0, 8); pf[2] = pack8(s1, 0); pf[3] = pack8(s1, 8);
  alpha = 1.f;
  if (!check) return false;
  const float rsum = sum + shx(sum, 32, lane);
  const bool trig = rsum > 65536.f;
  const bool resc = (__builtin_amdgcn_ballot_w64(trig) != 0ull);
  alpha = 1.f;
  if (resc) {
    const float d = trig ? (float)(__builtin_amdgcn_frexp_expf(rsum) - 7) : 0.f;
    alpha = __builtin_amdgcn_exp2f(-d);
    m += d; l *= alpha;
  }
  return resc;
}
DI int tr_base(int lane, int RS) {
  const int hh = lane >> 5, g1 = (lane >> 4) & 1, q = (lane >> 2) & 3, pp = lane & 3;
  return (4 * hh + q) * RS + (16 * g1 + 4 * pp) * 2;
}
DI bf16x8 ld_vfrag_tr(const char* vs, int vbase, int RS, int koff, int coff) {
  const char* a = vs + vbase + koff * RS + coff * 2;
  const s16x4 lo = __builtin_amdgcn_ds_read_tr16_b64_v4i16((LAS s16x4*)a);
  const s16x4 hi = __builtin_amdgcn_ds_read_tr16_b64_v4i16((LAS s16x4*)(a + 8 * RS));
  return __builtin_shufflevector(lo, hi, 0, 1, 2, 3, 4, 5, 6, 7);
}
DI bf16x8 ld_vfrag_s(const char* vs, int stride, int dvrow, int keyoff, int s, int hh) {
  const char* a = vs + dvrow * stride + (keyoff + 16 * s + 4 * hh) * 2;
  s16x4 lo = *(const s16x4*)a;
  s16x4 hi = *(const s16x4*)(a + 16);
  return __builtin_shufflevector(lo, hi, 0, 1, 2, 3, 4, 5, 6, 7);
}
DI void st_vt_s(char* vs, int stride, int dvrow, int part, u32x4 v) {
  char* a = vs + dvrow * stride + part * 16;
  *(u32x2*)a = (u32x2){v.x, v.y};
  *(u32x2*)(a + 8) = (u32x2){v.z, v.w};
}
DI bf16x8 ld_vfrag(const char* vs, int dvrow, int s, int hh) {
  const char* a = vs + dvrow * 136 + (16 * s + 4 * hh) * 2;
  s16x4 lo = *(const s16x4*)a;
  s16x4 hi = *(const s16x4*)(a + 16);
  return __builtin_shufflevector(lo, hi, 0, 1, 2, 3, 4, 5, 6, 7);
}
DI void st_vt(char* vs, int dvrow, int part, u32x4 v) {
  char* a = vs + dvrow * 136 + part * 16;
  *(u32x2*)a = (u32x2){v.x, v.y};
  *(u32x2*)(a + 8) = (u32x2){v.z, v.w};
}
DI void scale16(f32x16& o, float a) {
#pragma unroll
  for (int i = 0; i < 16; ++i) o[i] *= a;
}

DI void attn_mla_unit(const Params& p, int b, int h, int qb, char* smem, bool pre, int nh, bool has_next) {
  const int tid = get_tid(), lane = tid & 63, w = tid >> 6, r32 = lane & 31, hh = lane >> 5;
  char* big = p.ws + B_BIG;
  const u16* qmla = (const u16*)(big + E_QMLA);
  const u16* knope = (const u16*)(big + E_KNOPE);
  const u16* kpe = (const u16*)(big + E_KPE);
  const u16* vT = (const u16*)(big + E_VMLAT);
  u16* o = (u16*)(p.ws + B_H);
  constexpr int KR = 208, VR = 192;
  constexpr int STG = 128 * KR + 128 * VR;
  const int vbase = tr_base(lane, VR);
  const int qrow = b * S_ + qb * 256 + w * 32 + r32;
  bf16x8 qf[6];
#pragma unroll
  for (int s = 0; s < 6; ++s) qf[s] = *(const bf16x8*)(qmla + (size_t)qrow * 768 + h * 96 + s * 16 + hh * 8);
  f32x16 O0, O1;
#pragma unroll
  for (int i = 0; i < 16; ++i) { O0[i] = 0.f; O1[i] = 0.f; }
  float m = 0.f, l = 0.f;
  const int krow = tid >> 3, kpart = tid & 7;
  const int prow = tid >> 2, ppart = tid & 3;
  const int vrow = tid >> 3, vpart = tid & 7;
  const u16* gk = knope + (size_t)(b * S_ + krow) * 512 + h * 64 + kpart * 8;
  const u16* gp = kpe + (size_t)(b * S_ + prow) * 32 + ppart * 8;
  const u16* gv = vT + (size_t)(b * S_ + vrow) * 512 + h * 64 + vpart * 8;
  u32x4 rk[2], rp, rv[2];
  if (!pre) {
#pragma unroll
    for (int i = 0; i < 2; ++i) { rk[i] = *(const u32x4*)(gk + (size_t)i * 64 * 512); rv[i] = *(const u32x4*)(gv + (size_t)i * 64 * 512); }
    rp = *(const u32x4*)gp;
  }
  auto put_stage = [&](char* kb) {
    char* vb = kb + 128 * KR;
#pragma unroll
    for (int i = 0; i < 2; ++i) {
      *(u32x4*)(kb + (krow + 64 * i) * KR + kpart * 16) = rk[i];
      *(u32x4*)(vb + (vrow + 64 * i) * VR + vpart * 16) = rv[i];
    }
    *(u32x4*)(kb + prow * KR + 128 + ppart * 16) = rp;
  };
  auto get_stage = [&](int st) {
    const int k0 = st * 128;
#pragma unroll
    for (int i = 0; i < 2; ++i) { rk[i] = *(const u32x4*)(gk + (size_t)(k0 + i * 64) * 512); rv[i] = *(const u32x4*)(gv + (size_t)(k0 + i * 64) * 512); }
    rp = *(const u32x4*)(gp + (size_t)k0 * 32);
  };
  __syncthreads();
  if (!pre) put_stage(smem);
  __syncthreads();
  get_stage(1);
  for (int kt = 0; kt < 32; ++kt) {
    const char* ks = smem + (kt & 1) * STG; const char* vs = ks + 128 * KR;
#pragma unroll
    for (int sub = 0; sub < 2; ++sub) {
      f32x16 s0, s1;
#pragma unroll
      for (int i = 0; i < 16; ++i) { s0[i] = -m; s1[i] = -m; }
      {
        bf16x8 kf[12];
#pragma unroll
        for (int s = 0; s < 6; ++s) {
          kf[2 * s] = *(const bf16x8*)(ks + (sub * 64 + r32) * KR + (s * 16 + hh * 8) * 2);
          kf[2 * s + 1] = *(const bf16x8*)(ks + (sub * 64 + 32 + r32) * KR + (s * 16 + hh * 8) * 2);
        }
        __builtin_amdgcn_sched_barrier(0); __builtin_amdgcn_s_setprio(1);
#pragma unroll
        for (int s = 0; s < 6; ++s) { s0 = mfma32(kf[2 * s], qf[s], s0); s1 = mfma32(kf[2 * s + 1], qf[s], s1); }
      __builtin_amdgcn_s_setprio(0);
}
      float alpha; bf16x8 pf[4];
      const bool resc = softmax_tile(s0, s1, m, l, alpha, pf, lane, (kt == 0) && (sub == 0), sub == 0);
      {
        bf16x8 vf[8];
#pragma unroll
        for (int s = 0; s < 4; ++s) { vf[2 * s] = ld_vfrag_tr(vs, vbase, VR, sub * 64 + 16 * s, 0); vf[2 * s + 1] = ld_vfrag_tr(vs, vbase, VR, sub * 64 + 16 * s, 32); }
        __builtin_amdgcn_sched_barrier(0); __builtin_amdgcn_s_setprio(1);
#pragma unroll
        for (int s = 0; s < 4; ++s) { O0 = mfma32(vf[2 * s], pf[s], O0); O1 = mfma32(vf[2 * s + 1], pf[s], O1); }
      __builtin_amdgcn_s_setprio(0);
}
      if (resc) { scale16(O0, alpha); scale16(O1, alpha); }
    }
    if (kt + 1 < 32) put_stage(smem + ((kt + 1) & 1) * STG);
    else if (has_next) put_stage(smem);
    __syncthreads();
    if (kt + 2 < 32) get_stage(kt + 2);
    else if (kt == 30 && has_next) { gk += (nh - h) * 64; gv += (nh - h) * 64; get_stage(0); }
  }
  const float lt = l + shx(l, 32, lane);
  const float inv = 1.f / lt;
  u16* op = o + (size_t)qrow * 1024 + h * 64 + 4 * hh;
#pragma unroll
  for (int i4 = 0; i4 < 4; ++i4) {
    st_bf4(op + 8 * i4, (f32x4){O0[4 * i4], O0[4 * i4 + 1], O0[4 * i4 + 2], O0[4 * i4 + 3]}, inv);
    st_bf4(op + 32 + 8 * i4, (f32x4){O1[4 * i4], O1[4 * i4 + 1], O1[4 * i4 + 2], O1[4 * i4 + 3]}, inv);
  }
}

DI void attn_na_unit(const Params& p, int li, int b, int r, int hp, char* smem) {
  const int tid = get_tid() & 255, lane = tid & 63, w = tid >> 6, r32 = lane & 31, hh = lane >> 5;
  char* big = p.ws + B_BIG;
  const u16* qna = (const u16*)(big + E_QNA);
  const u16* kna = (const u16*)(big + E_KNA);
  const u16* vT = (const u16*)(big + E_VNAT);
  u16* o = (u16*)(p.ws + B_H);
  char* ks = smem; char* vs = smem + SM_ATT_V; float* tab = (float*)(smem + SM_ATT_TAB);
  constexpr int KR = 272, VR = 320;
  const int vbase = tr_base(lane, VR);
  const int qbk = w & 1, hs = w >> 1, head = 2 * hp + hs;
  const int wq = 32 * qbk + r32;
  const int qrow = b * S_ + r * 64 + wq;
  int cs = wq - 8; cs = cs < 0 ? 0 : (cs > 48 ? 48 : cs);
  int rs = r - 4; rs = rs < 0 ? 0 : (rs > 56 ? 56 : rs);
  __syncthreads();
  for (int idx = tid; idx < 2 * 465; idx += 256) {
    int hsel = idx >= 465 ? 1 : 0; int rem = idx - hsel * 465;
    tab[idx] = p.ab_rpb[((size_t)(li * 8 + 2 * hp + hsel)) * 465 + rem] * LOG2E;
  }
  bf16x8 qf[4];
#pragma unroll
  for (int s = 0; s < 4; ++s) qf[s] = *(const bf16x8*)(qna + (size_t)qrow * 512 + head * 64 + s * 16 + hh * 8);
  f32x16 O0, O1;
#pragma unroll
  for (int i = 0; i < 16; ++i) { O0[i] = 0.f; O1[i] = 0.f; }
  float m = 0.f, l = 0.f;
  const int krow = tid >> 4, kpart = tid & 15;
  const u16* gk = kna + (size_t)(b * S_ + rs * 64 + krow) * 512 + hp * 128 + kpart * 8;
  const u16* gv = vT + (size_t)(b * S_ + rs * 64 + krow) * 512 + hp * 128 + kpart * 8;
  u32x4 rk[4], rv[4];
#pragma unroll
  for (int i = 0; i < 4; ++i) { rk[i] = *(const u32x4*)(gk + (size_t)i * 16 * 512); rv[i] = *(const u32x4*)(gv + (size_t)i * 16 * 512); }
  for (int kt = 0; kt < 8; ++kt) {
    __syncthreads();
#pragma unroll
    for (int i = 0; i < 4; ++i) {
      *(u32x4*)(ks + (krow + 16 * i) * KR + kpart * 16) = rk[i];
      *(u32x4*)(vs + (krow + 16 * i) * VR + kpart * 16) = rv[i];
    }
    __syncthreads();
    if (kt + 1 < 8) {
      const int k0 = (kt + 1) * 64;
#pragma unroll
      for (int i = 0; i < 4; ++i) { rk[i] = *(const u32x4*)(gk + (size_t)(k0 + i * 16) * 512); rv[i] = *(const u32x4*)(gv + (size_t)(k0 + i * 16) * 512); }
    }
    f32x16 s0, s1;
#pragma unroll
    for (int i = 0; i < 16; ++i) { s0[i] = -m; s1[i] = -m; }
    {
      bf16x8 kf[8];
#pragma unroll
      for (int s = 0; s < 4; ++s) {
        kf[2 * s] = *(const bf16x8*)(ks + r32 * KR + (hs * 64 + s * 16 + hh * 8) * 2);
        kf[2 * s + 1] = *(const bf16x8*)(ks + (32 + r32) * KR + (hs * 64 + s * 16 + hh * 8) * 2);
      }
      __builtin_amdgcn_sched_barrier(0); __builtin_amdgcn_s_setprio(1);
#pragma unroll
      for (int s = 0; s < 4; ++s) { s0 = mfma32(kf[2 * s], qf[s], s0); s1 = mfma32(kf[2 * s + 1], qf[s], s1); }
    __builtin_amdgcn_s_setprio(0);
}
    const int drow = rs + kt - r + 7;
    const float* trow = tab + hs * 465 + drow * 31;
#pragma unroll
    for (int i = 0; i < 16; ++i) {
      const int kc0 = (i & 3) + 8 * (i >> 2) + 4 * hh;
      const int kc1 = kc0 + 32;
      const bool v0 = (unsigned)(kc0 - cs) < 16u;
      const bool v1 = (unsigned)(kc1 - cs) < 16u;
      const int d0 = v0 ? (kc0 - wq + 15) : 0;
      const int d1 = v1 ? (kc1 - wq + 15) : 0;
      const float b0 = trow[d0], b1 = trow[d1];
      s0[i] = v0 ? s0[i] + b0 : -1e30f;
      s1[i] = v1 ? s1[i] + b1 : -1e30f;
    }
    float alpha; bf16x8 pf[4];
    const bool resc = softmax_tile(s0, s1, m, l, alpha, pf, lane, kt == 0, true);
    {
      bf16x8 vf[8];
#pragma unroll
      for (int s = 0; s < 4; ++s) { vf[2 * s] = ld_vfrag_tr(vs, vbase, VR, 16 * s, hs * 64); vf[2 * s + 1] = ld_vfrag_tr(vs, vbase, VR, 16 * s, hs * 64 + 32); }
      __builtin_amdgcn_sched_barrier(0); __builtin_amdgcn_s_setprio(1);
#pragma unroll
      for (int s = 0; s < 4; ++s) { O0 = mfma32(vf[2 * s], pf[s], O0); O1 = mfma32(vf[2 * s + 1], pf[s], O1); }
    __builtin_amdgcn_s_setprio(0);
}
    if (resc) { scale16(O0, alpha); scale16(O1, alpha); }
  }
  const float lt = l + shx(l, 32, lane);
  const float inv = 1.f / lt;
  u16* op = o + (size_t)qrow * 1024 + 512 + head * 64 + 4 * hh;
#pragma unroll
  for (int i4 = 0; i4 < 4; ++i4) {
    st_bf4(op + 8 * i4, (f32x4){O0[4 * i4], O0[4 * i4 + 1], O0[4 * i4 + 2], O0[4 * i4 + 3]}, inv);
    st_bf4(op + 32 + 8 * i4, (f32x4){O1[4 * i4], O1[4 * i4 + 1], O1[4 * i4 + 2], O1[4 * i4 + 3]}, inv);
  }
}

DI void attn_diff_unit(const Params& p, int li, int b, int h, int qb, char* smem, bool pre, int nh, bool has_next) {
  const int tid = get_tid(), lane = tid & 63, w = tid >> 6, r32 = lane & 31, hh = lane >> 5;
  char* big = p.ws + B_BIG;
  const u16* qd = (const u16*)(big + O_QD);
  const u16* kd = (const u16*)(big + O_KD);
  const u16* vT = (const u16*)(big + O_VDT);
  u16* o = (u16*)(p.ws + B_H);
  constexpr int KR = 272, VR = 320;
  constexpr int STG = 128 * KR + 128 * VR;
  const int vbase = tr_base(lane, VR);
  float* tab = (float*)(smem + 2 * STG);
  const int rg = w & 3, map = w >> 2;
  const int qpos = qb * 128 + rg * 32 + r32;
  const int qrow = b * S_ + qpos;
  __syncthreads();
  const float* t5t = (const float*)(p.ws + TB_T5) + h * 512;
  if (tid < 512) tab[tid] = t5t[tid];
  const float cL = t5t[0], cR = t5t[510];
  bf16x8 qf[4];
#pragma unroll
  for (int s = 0; s < 4; ++s) qf[s] = *(const bf16x8*)(qd + (size_t)qrow * 1024 + h * 128 + map * 64 + s * 16 + hh * 8);
  f32x16 O[4];
#pragma unroll
  for (int j = 0; j < 4; ++j)
#pragma unroll
    for (int i = 0; i < 16; ++i) O[j][i] = 0.f;
  float m = 0.f, l = 0.f;
  const int krow = tid >> 4, kpart = tid & 15;
  const u16* gk = kd + (size_t)(b * S_ + krow) * 1024 + h * 128 + kpart * 8;
  const u16* gv = vT + (size_t)(b * S_ + krow) * 1024 + h * 128 + kpart * 8;
  u32x4 rk[4], rv[4];
  if (!pre) {
#pragma unroll
    for (int i = 0; i < 4; ++i) { rk[i] = *(const u32x4*)(gk + (size_t)i * 32 * 1024); rv[i] = *(const u32x4*)(gv + (size_t)i * 32 * 1024); }
  }
  auto put_stage = [&](char* kb) {
    char* vb = kb + 128 * KR;
#pragma unroll
    for (int i = 0; i < 4; ++i) {
      *(u32x4*)(kb + (krow + 32 * i) * KR + kpart * 16) = rk[i];
      *(u32x4*)(vb + (krow + 32 * i) * VR + kpart * 16) = rv[i];
    }
  };
  auto get_stage = [&](int st) {
    const int k0 = st * 128;
#pragma unroll
    for (int i = 0; i < 4; ++i) { rk[i] = *(const u32x4*)(gk + (size_t)(k0 + i * 32) * 1024); rv[i] = *(const u32x4*)(gv + (size_t)(k0 + i * 32) * 1024); }
  };
  if (!pre) put_stage(smem);
  __syncthreads();
  get_stage(1);
  for (int kt = 0; kt < 32; ++kt) {
    const char* ks = smem + (kt & 1) * STG; const char* vs = ks + 128 * KR;
#pragma unroll
    for (int sub = 0; sub < 2; ++sub) {
      const int kbase = kt * 128 + sub * 64;
      const int relmin = kbase - (qb * 128 + 127), relmax = kbase + 63 - qb * 128;
      const float cb = (relmin >= 128) ? cR : ((relmax <= -128) ? cL : 0.f);
      f32x16 s0, s1;
#pragma unroll
      for (int i = 0; i < 16; ++i) { s0[i] = cb - m; s1[i] = cb - m; }
      {
        bf16x8 kf[8];
#pragma unroll
        for (int s = 0; s < 4; ++s) {
          kf[2 * s] = *(const bf16x8*)(ks + (sub * 64 + r32) * KR + (map * 64 + s * 16 + hh * 8) * 2);
          kf[2 * s + 1] = *(const bf16x8*)(ks + (sub * 64 + 32 + r32) * KR + (map * 64 + s * 16 + hh * 8) * 2);
        }
        __builtin_amdgcn_sched_barrier(0); __builtin_amdgcn_s_setprio(1);
#pragma unroll
        for (int s = 0; s < 4; ++s) { s0 = mfma32(kf[2 * s], qf[s], s0); s1 = mfma32(kf[2 * s + 1], qf[s], s1); }
      __builtin_amdgcn_s_setprio(0);
}
      if (relmin < 128 && relmax > -128) {
        const int base = kbase - qpos + 255 + 4 * hh;
#pragma unroll
        for (int i = 0; i < 16; ++i) {
          int i0 = base + (i & 3) + 8 * (i >> 2);
          int i1 = i0 + 32;
          i0 = i0 < 0 ? 0 : (i0 > 510 ? 510 : i0);
          i1 = i1 < 0 ? 0 : (i1 > 510 ? 510 : i1);
          s0[i] += tab[i0]; s1[i] += tab[i1];
        }
      }
      float alpha; bf16x8 pf[4];
      const bool resc = softmax_tile(s0, s1, m, l, alpha, pf, lane, (kt == 0) && (sub == 0), sub == 0);
      {
        bf16x8 vf[2][4];
#pragma unroll
        for (int j = 0; j < 4; ++j) vf[0][j] = ld_vfrag_tr(vs, vbase, VR, sub * 64, j * 32);
#pragma unroll
        for (int s = 0; s < 4; ++s) {
          if (s < 3) {
#pragma unroll
            for (int j = 0; j < 4; ++j) vf[(s + 1) & 1][j] = ld_vfrag_tr(vs, vbase, VR, sub * 64 + 16 * (s + 1), j * 32);
          }
          __builtin_amdgcn_sched_barrier(0); __builtin_amdgcn_s_setprio(1);
#pragma unroll
          for (int j = 0; j < 4; ++j) O[j] = mfma32(vf[s & 1][j], pf[s], O[j]);
        __builtin_amdgcn_s_setprio(0);
}
      }
      if (resc) {
#pragma unroll
        for (int j = 0; j < 4; ++j) scale16(O[j], alpha);
      }
    }
    if (kt + 1 < 32) put_stage(smem + ((kt + 1) & 1) * STG);
    else if (has_next) put_stage(smem);
    __syncthreads();
    if (kt + 2 < 32) get_stage(kt + 2);
    else if (kt == 30 && has_next) { gk += (nh - h) * 128; gv += (nh - h) * 128; get_stage(0); }
  }
  const float lt = l + shx(l, 32, lane);
  const float inv = 1.f / lt;
  float* xch = (float*)(smem + STG);
  if (map == 1) {
#pragma unroll
    for (int j = 0; j < 4; ++j)
#pragma unroll
      for (int i = 0; i < 16; ++i) xch[(rg * 64 + j * 16 + i) * 64 + lane] = O[j][i] * inv;
  }
  __syncthreads();
  if (map == 0) {
    const float lam = ((const float*)(p.ws + TB_LAM))[li];
    const int layer = 2 * li + 1;
    const float linit = 0.8f - 0.6f * expf(-0.3f * (float)layer);
    float ss = 0.f;
#pragma unroll
    for (int j = 0; j < 4; ++j)
#pragma unroll
      for (int i = 0; i < 16; ++i) {
        float v = O[j][i] * inv - lam * xch[(rg * 64 + j * 16 + i) * 64 + lane];
        O[j][i] = v; ss += v * v;
      }
    ss += shx(ss, 32, lane);
    const float rinv = rsqrtf(ss * (1.f / 128.f) + EPS) * (1.f - linit);
    const float* sub = p.c_subln + li * 128;
    u16* op = o + (size_t)qrow * 1024 + h * 128 + 4 * hh;
#pragma unroll
    for (int j = 0; j < 4; ++j)
#pragma unroll
      for (int i4 = 0; i4 < 4; ++i4) {
        const int dv = j * 32 + 8 * i4 + 4 * hh;
        const f32x4 g4 = *(const f32x4*)(sub + dv);
        f32x4 v = {O[j][4 * i4] * g4[0], O[j][4 * i4 + 1] * g4[1], O[j][4 * i4 + 2] * g4[2], O[j][4 * i4 + 3] * g4[3]};
        st_bf4(op + j * 32 + 8 * i4, v, rinv);
      }
  }
}

#define XB_TMO      128
#define XB_XCNT(j)  (256  + 64 * (j))
#define XB_XSUB(j)  (1280 + 64 * (j))
#define XB_XGEN(j)  (2304 + 64 * (j))
#define XB_TOP      3328
#define XB_TOPGEN   3392
#define XCD_BAR_WORDS 3456
#define XB_SPIN_CAP (1u << 18)
DI unsigned xb_ld(unsigned* p)              { return __hip_atomic_load(p, __ATOMIC_RELAXED, __HIP_MEMORY_SCOPE_AGENT); }
DI unsigned xb_add(unsigned* p, unsigned v) { return __hip_atomic_fetch_add(p, v, __ATOMIC_RELAXED, __HIP_MEMORY_SCOPE_AGENT); }
DI unsigned xb_xcc_id() { return (unsigned)__builtin_amdgcn_s_getreg((3 << 11) | 20) & 0xFu; }
#define XB_SPIN(cond, bar) do { unsigned _sp = 0; while (cond) { __builtin_amdgcn_s_sleep(1); \
    if ((++_sp & 255u) == 0u) { if (xb_ld(&(bar)[XB_TMO])) break; if (_sp > XB_SPIN_CAP) { atomicAdd(&(bar)[XB_TMO], 1u); break; } } } } while (0)
struct XcdBarrier { unsigned* bar; unsigned x; volatile LAS unsigned* st; };
DI XcdBarrier xcd_barrier_post(unsigned* bar, volatile LAS unsigned* st) {
  XcdBarrier b; b.bar = bar; b.x = xb_xcc_id(); b.st = st;
  if (threadIdx.x == 0) (void)xb_add(&bar[XB_XCNT(b.x)], 1u);
  return b;
}
DI void xcd_barrier_complete(unsigned* bar, unsigned x, unsigned& nloc, unsigned& nx) {
  const unsigned G = gridDim.x * gridDim.y * gridDim.z;
  unsigned sum, cnt, mine, sp = 0u;
  for (;;) {
    sum = 0u; cnt = 0u; mine = 0u;
#pragma unroll
    for (unsigned j = 0; j < 16; ++j) { const unsigned c = xb_ld(&bar[XB_XCNT(j)]); sum += c; cnt += (c > 0u) ? 1u : 0u; mine = (j == x) ? c : mine; }
    if (sum == G) break;
    __builtin_amdgcn_s_sleep(1);
    if ((++sp & 255u) == 0u) { if (xb_ld(&bar[XB_TMO])) break; if (sp > XB_SPIN_CAP) { atomicAdd(&bar[XB_TMO], 1u); break; } }
  }
  nloc = mine > 0u ? mine : 1u; nx = cnt > 0u ? cnt : 1u;
}
DI void xcd_barrier(const XcdBarrier& b) {
  asm volatile("s_waitcnt vmcnt(0)" ::: "memory");
  __syncthreads();
  if (threadIdx.x == 0) {
    size_t zb = 0; asm volatile("" : "+s"(zb));
    unsigned* bar = b.bar + zb;
    __builtin_amdgcn_s_waitcnt(0);
    unsigned nloc = b.st[0], nx = b.st[1];
    if (nloc == 0u) { xcd_barrier_complete(bar, b.x, nloc, nx); b.st[0] = nloc; b.st[1] = nx; }
    const unsigned old = xb_add(&bar[XB_XSUB(b.x)], 1u);
    const unsigned gen = old / nloc;
    if (old + 1u == (gen + 1u) * nloc) {
      __builtin_amdgcn_fence(__ATOMIC_RELEASE, "agent");
      asm volatile("s_waitcnt vmcnt(0)" ::: "memory");
      const unsigned og = xb_add(&bar[XB_TOP], 1u);
      const unsigned tg = og / nx;
      if (og + 1u == (tg + 1u) * nx) xb_add(&bar[XB_TOPGEN], 1u);
      else XB_SPIN(xb_ld(&bar[XB_TOPGEN]) == tg, bar);
      __builtin_amdgcn_fence(__ATOMIC_ACQUIRE, "agent");
      xb_add(&bar[XB_XGEN(b.x)], 1u);
      asm volatile("s_waitcnt vmcnt(0)" ::: "memory");
    } else {
      XB_SPIN(xb_ld(&bar[XB_XGEN(b.x)]) == gen, bar);
      __builtin_amdgcn_fence(__ATOMIC_ACQUIRE, "agent");
      asm volatile("s_waitcnt vmcnt(0)" ::: "memory");
    }
  }
  __syncthreads();
}

#define LAUNDER(q)  Params q = p; { size_t zoff = 0; asm volatile("" : "+s"(zoff)); q.ws = p.ws + zoff; q.xres = p.xres + zoff; q.x = p.x + zoff; }
#define PH_BEGIN(n) if (ph_lo <= (n) && (n) < ph_hi) { LAUNDER(q); char* ws = q.ws; (void)ws;
#define PH_END(n)   if ((n) + 1 < ph_hi) { xcd_barrier(xb); } }

__global__ void __launch_bounds__(512) mega(Params p, int ph_lo, int ph_hi) {
  extern __shared__ __attribute__((aligned(16))) unsigned char lds_raw[];
  LAS unsigned char* lds = (LAS unsigned char*)lds_raw;
  char* smem = (char*)lds_raw;
  const int nx = gridDim.x >> 3, xcd = blockIdx.x & 7, jx = blockIdx.x >> 3;
  volatile LAS unsigned* bst = (volatile LAS unsigned*)(lds + SM_BARST);
  if (threadIdx.x < 2) bst[threadIdx.x] = 0u;
  __syncthreads();
  const XcdBarrier xb = xcd_barrier_post((unsigned*)(p.ws + TB_BAR), bst);

  if (ph_lo < 0) cg::this_grid().sync();
  PH_BEGIN(0) phase_prep(q, smem); PH_END(0)

#pragma unroll 1
  for (int L = 0; L < 4; ++L) {
    const int pb = 1 + 8 * L, li = L >> 1;
    const bool even = (L & 1) == 0;
    if (even) {
      PH_BEGIN(pb + 1)
        run_gemm<EPI_ABIN>(lds, (const u16*)(ws + B_XR), (const u16*)(ws + W_ABIN) + (size_t)li * 2304 * 1024, 2304, 1024, q, nullptr, (const float*)(ws + TB_SSA), nullptr);
      PH_END(pb + 1)
      PH_BEGIN(pb + 2)
        run_gemm<EPI_UQ>(lds, (const u16*)(ws + B_BIG + E_CQ), (const u16*)(ws + W_UQ) + (size_t)li * 768 * 384, 768, 384, q, nullptr, nullptr, nullptr);
        run_gemm<EPI_UKV>(lds, (const u16*)(ws + B_BIG + E_CKV), (const u16*)(ws + W_UKV) + (size_t)li * 1024 * 256, 1024, 256, q, nullptr, nullptr, nullptr);
      PH_END(pb + 2)
      PH_BEGIN(pb + 3)
        if (jx < nx) {
          const int half = get_tid() >> 8;
          char* sm = smem + half * ATT_HALF;
#pragma unroll 1
          for (int u = jx; u < 128; u += nx) attn_mla_unit(q, xcd, u >> 4, u & 15, smem, u != jx, (u + nx) >> 4, u + nx < 128);
#pragma unroll 1
          for (int up = jx; up < 128; up += nx) { const int u = 2 * up + half; attn_na_unit(q, li, xcd, u >> 2, u & 3, sm); }
        }
      PH_END(pb + 3)
    } else {
      PH_BEGIN(pb + 1)
        run_gemm<EPI_CIN>(lds, (const u16*)(ws + B_XR), (const u16*)(ws + W_CIN) + (size_t)li * 3072 * 1024, 3072, 1024, q, nullptr, (const float*)(ws + TB_SSA), nullptr);
      PH_END(pb + 1)
      PH_BEGIN(pb + 3)
        if (jx < nx) {
          const int half = get_tid() >> 8;
          char* sm = smem + half * ATT_HALF;
#pragma unroll 1
          for (int u = jx; u < 256; u += nx) attn_diff_unit(q, li, xcd, u >> 5, u & 31, smem, u != jx, (u + nx) >> 5, u + nx < 256);
        }
      PH_END(pb + 3)
    }
    PH_BEGIN(pb + 4)
      run_gemm<EPI_RESID>(lds, (const u16*)(ws + B_H), (const u16*)(ws + (even ? W_ABOUT : W_COUT)) + (size_t)li * 1024 * 1024, 1024, 1024, q, (L == 0) ? q.x : nullptr, nullptr, (float*)(ws + TB_SSM));
    PH_END(pb + 4)
    PH_BEGIN(pb + 6)
      run_gemm<EPI_RELU2>(lds, (const u16*)(ws + B_XR), (const u16*)(ws + W_W1) + (size_t)L * 4096 * 1024, 4096, 1024, q, nullptr, (const float*)(ws + TB_SSM), nullptr);
    PH_END(pb + 6)
    PH_BEGIN(pb + 7)
      run_gemm<EPI_RESID>(lds, (const u16*)(ws + B_BIG), (const u16*)(ws + W_W2) + (size_t)L * 1024 * 4096, 1024, 4096, q, nullptr, nullptr, (float*)(ws + TB_SSA));
    PH_END(pb + 7)
  }

  PH_BEGIN(NPH - 1) phase_norm<true, true>(ws + B_XR, q.final_norm, nullptr, q.xres); PH_END(NPH - 1)
}

extern "C" void kernel_launch(void* const* d_in, const int* in_sizes, int n_in, void* d_out, int out_size,
                              void* d_ws, size_t ws_size, hipStream_t stream) {
  if (ws_size < WS_NEED) { fprintf(stderr, "workspace too small: %zu < %zu\n", ws_size, WS_NEED); return; }
  Params p{};
  p.x = (const float*)d_in[0]; p.norm_attn = (const float*)d_in[1]; p.norm_mlp = (const float*)d_in[2];
  p.ab_w_in = (const float*)d_in[3]; p.ab_q_norm = (const float*)d_in[4]; p.ab_w_uq = (const float*)d_in[5];
  p.ab_kv_norm = (const float*)d_in[6]; p.ab_w_ukv = (const float*)d_in[7]; p.ab_rpb = (const float*)d_in[8];
  p.ab_w_out = (const float*)d_in[9]; p.c_w_in = (const float*)d_in[10]; p.lq1 = (const float*)d_in[11];
  p.lk1 = (const float*)d_in[12]; p.lq2 = (const float*)d_in[13]; p.lk2 = (const float*)d_in[14];
  p.c_subln = (const float*)d_in[15]; p.c_w_out = (const float*)d_in[16]; p.t5 = (const float*)d_in[17];
  p.mlp_w1 = (const float*)d_in[18]; p.mlp_w2 = (const float*)d_in[19]; p.final_norm = (const float*)d_in[20];
  p.xres = (float*)d_out; p.ws = (char*)d_ws;

  static int grid_blocks = 0;
  if (!grid_blocks) {
    int dev = 0, cus = 0, per_cu = 0;
    (void)hipGetDevice(&dev);
    (void)hipDeviceGetAttribute(&cus, hipDeviceAttributeMultiprocessorCount, dev);
    if (hipFuncSetAttribute((const void*)mega, hipFuncAttributeMaxDynamicSharedMemorySize, SMEM_BYTES) != hipSuccess) { fprintf(stderr, "hipFuncSetAttribute failed\n"); grid_blocks = -1; return; }
    (void)hipOccupancyMaxActiveBlocksPerMultiprocessor(&per_cu, mega, NTHR, SMEM_BYTES);
    (void)hipGetLastError();
    grid_blocks = cus;
  }
  if (grid_blocks < 0) return;
#if MULTI_LAUNCH
  for (int ph = 0; ph < NPH; ++ph) {
    if (ph >= 1 && ph < NPH - 1 && ((ph - 1) & 7) == 2 && ((((ph - 1) >> 3) & 1) == 1)) continue;
    hipLaunchKernelGGL(mega, dim3(grid_blocks), dim3(NTHR), SMEM_BYTES, stream, p, ph, ph + 1);
  }
#else
  (void)hipMemsetAsync((char*)d_ws + TB_BAR, 0, 16384, stream);
  int lo = 0, hi = NPH;
  void* args[] = {&p, &lo, &hi};
  hipError_t e = hipLaunchCooperativeKernel((void*)mega, dim3(grid_blocks), dim3(NTHR), args, SMEM_BYTES, stream);
  if (e != hipSuccess) fprintf(stderr, "cooperative launch failed: %s (grid %d)\n", hipGetErrorString(e), grid_blocks);
#endif
}
```

```cpp
#include <hip/hip_runtime.h>
#include <hip/hip_cooperative_groups.h>
#include <cstdio>
namespace cg = cooperative_groups;

typedef unsigned short u16;
using bf16x8 = __attribute__((ext_vector_type(8))) short;
using s16x4  = __attribute__((ext_vector_type(4))) short;
using f32x4  = __attribute__((ext_vector_type(4))) float;
using f32x16 = __attribute__((ext_vector_type(16))) float;
using u32x4  = __attribute__((ext_vector_type(4))) unsigned;
using u32x2  = __attribute__((ext_vector_type(2))) unsigned;
typedef __bf16 bf2_t __attribute__((ext_vector_type(2)));
typedef float  fl2_t __attribute__((ext_vector_type(2)));
#define DI __device__ __forceinline__

#ifndef MULTI_LAUNCH
#define MULTI_LAUNCH 0
#endif

constexpr int T_ = 32768;
constexpr int S_ = 4096;
constexpr float LOG2E = 1.4426950408889634f;
constexpr float EPS = 1e-6f;
constexpr int NPH = 34;
constexpr int NTHR = 512;

constexpr size_t W_ABIN  = 0;
constexpr size_t W_UQ    = W_ABIN  + 2ull * 2304 * 1024 * 2;
constexpr size_t W_UKV   = W_UQ    + 2ull * 768 * 384 * 2;
constexpr size_t W_ABOUT = W_UKV   + 2ull * 1024 * 256 * 2;
constexpr size_t W_CIN   = W_ABOUT + 2ull * 1024 * 1024 * 2;
constexpr size_t W_COUT  = W_CIN   + 2ull * 3072 * 1024 * 2;
constexpr size_t W_W1    = W_COUT  + 2ull * 1024 * 1024 * 2;
constexpr size_t W_W2    = W_W1    + 4ull * 4096 * 1024 * 2;
constexpr size_t TB_COS  = W_W2    + 4ull * 4096 * 1024 * 2;
constexpr size_t TB_SIN  = TB_COS  + 4096ull * 16 * 4;
constexpr size_t TB_T5   = TB_SIN  + 4096ull * 16 * 4;
constexpr size_t TB_LAM  = TB_T5   + 8ull * 512 * 4;
constexpr size_t TB_SSA  = TB_LAM  + 256;
constexpr size_t TB_SSM  = TB_SSA  + (size_t)T_ * 16 * 4;
constexpr size_t TB_BAR  = TB_SSM  + (size_t)T_ * 16 * 4;
constexpr size_t B_H     = TB_BAR  + 16384;
constexpr size_t B_BIG   = B_H     + (size_t)T_ * 1024 * 2;
constexpr size_t E_CQ    = 0;
constexpr size_t E_CKV   = E_CQ    + (size_t)T_ * 384 * 2;
constexpr size_t E_KPE   = E_CKV   + (size_t)T_ * 256 * 2;
constexpr size_t E_QNA   = E_KPE   + (size_t)T_ * 32 * 2;
constexpr size_t E_KNA   = E_QNA   + (size_t)T_ * 512 * 2;
constexpr size_t E_VNAT  = E_KNA   + (size_t)T_ * 512 * 2;
constexpr size_t E_QMLA  = E_VNAT  + (size_t)T_ * 512 * 2;
constexpr size_t E_KNOPE = E_QMLA  + (size_t)T_ * 768 * 2;
constexpr size_t E_VMLAT = E_KNOPE + (size_t)T_ * 512 * 2;
constexpr size_t E_END   = E_VMLAT + (size_t)T_ * 512 * 2;
static_assert(E_END <= (size_t)T_ * 4096 * 2, "even buffers exceed BIG");
constexpr size_t O_QD    = 0;
constexpr size_t O_KD    = O_QD + (size_t)T_ * 1024 * 2;
constexpr size_t O_VDT   = O_KD + (size_t)T_ * 1024 * 2;
constexpr size_t B_XR    = B_BIG + (size_t)T_ * 4096 * 2;
constexpr size_t WS_NEED = B_XR + (size_t)T_ * 1024 * 2;

struct Params {
  const float* x; const float* norm_attn; const float* norm_mlp; const float* ab_w_in; const float* ab_q_norm;
  const float* ab_w_uq; const float* ab_kv_norm; const float* ab_w_ukv; const float* ab_rpb; const float* ab_w_out;
  const float* c_w_in; const float* lq1; const float* lk1; const float* lq2; const float* lk2; const float* c_subln;
  const float* c_w_out; const float* t5; const float* mlp_w1; const float* mlp_w2; const float* final_norm;
  float* xres; char* ws;
};

DI unsigned pack2(float a, float b) {
  fl2_t f = {a, b};
  bf2_t r = __builtin_convertvector(f, bf2_t);
  return __builtin_bit_cast(unsigned, r);
}
DI u16 f2bf(float x) { unsigned u = __float_as_uint(x); u += 0x7fffu + ((u >> 16) & 1u); return (u16)(u >> 16); }
DI float bf2f(unsigned v) { return __uint_as_float(v << 16); }
DI void st_bf4(u16* p, f32x4 v, float sc) {
  u32x2 u; u.x = pack2(v[0] * sc, v[1] * sc); u.y = pack2(v[2] * sc, v[3] * sc);
  *(u32x2*)p = u;
}
DI void st_bf8(u16* p, f32x4 a, f32x4 b, float sc) {
  u32x4 u; u.x = pack2(a[0] * sc, a[1] * sc); u.y = pack2(a[2] * sc, a[3] * sc); u.z = pack2(b[0] * sc, b[1] * sc); u.w = pack2(b[2] * sc, b[3] * sc);
  *(u32x4*)p = u;
}
DI void st_T(u16* p, f32x4 v, float sc) {
#pragma unroll
  for (int i = 0; i < 4; ++i) p[(size_t)i * S_] = f2bf(v[i] * sc);
}
DI int get_tid() { int t = threadIdx.x; asm volatile("" : "+v"(t)); return t; }
DI float shx(float v, int mask, int lane) {
  return __int_as_float(__builtin_amdgcn_ds_bpermute((lane ^ mask) << 2, __float_as_int(v)));
}
DI float wave_sum(float v, int lane) {
#pragma unroll
  for (int o = 32; o > 0; o >>= 1) v += shx(v, o, lane);
  return v;
}
DI f32x16 mfma32(bf16x8 a, bf16x8 b, f32x16 c) { return __builtin_amdgcn_mfma_f32_32x32x16_bf16(a, b, c, 0, 0, 0); }
DI f32x4 mfma16(bf16x8 a, bf16x8 b, f32x4 c) { return __builtin_amdgcn_mfma_f32_16x16x32_bf16(a, b, c, 0, 0, 0); }
DI bf16x8 pack8(const f32x16& s, int o) {
  u32x4 u;
  u.x = pack2(s[o + 0], s[o + 1]); u.y = pack2(s[o + 2], s[o + 3]);
  u.z = pack2(s[o + 4], s[o + 5]); u.w = pack2(s[o + 6], s[o + 7]);
  return __builtin_bit_cast(bf16x8, u);
}

DI void prep_wt(const float* __restrict__ src, u16* __restrict__ dst, int K, int N, int Npad,
                const float* __restrict__ gain, float* tile) {
  const int tid = get_tid();
  const int tk = K / 64, tn = Npad / 64, nt4 = tk * tn;
  constexpr int TS = 64 * 65;
  for (int t0 = blockIdx.x; t0 < nt4; t0 += 4 * gridDim.x) {
    f32x4 v[4][2];
#pragma unroll
    for (int j = 0; j < 4; ++j) {
      const int t = t0 + j * gridDim.x;
      const int kt = t % tk, nt = t / tk;
#pragma unroll
      for (int i = 0; i < 2; ++i) {
        const int e = tid + NTHR * i; const int kk = e >> 4, n4 = (e & 15) * 4; const int n = nt * 64 + n4;
        v[j][i] = (f32x4){0.f, 0.f, 0.f, 0.f};
        if (t < nt4 && n < N) {
          v[j][i] = *(const f32x4*)(src + (size_t)(kt * 64 + kk) * N + n);
          if (gain) v[j][i] *= gain[kt * 64 + kk];
        }
      }
    }
    __syncthreads();
#pragma unroll
    for (int j = 0; j < 4; ++j)
#pragma unroll
      for (int i = 0; i < 2; ++i) {
        const int e = tid + NTHR * i; const int kk = e >> 4, n4 = (e & 15) * 4;
        float* tp = tile + j * TS + kk * 65 + n4;
        tp[0] = v[j][i][0]; tp[1] = v[j][i][1]; tp[2] = v[j][i][2]; tp[3] = v[j][i][3];
      }
    __syncthreads();
#pragma unroll
    for (int j = 0; j < 4; ++j) {
      const int t = t0 + j * gridDim.x;
      if (t < nt4) {
        const int kt = t % tk, nt = t / tk;
        const int nn = tid >> 3, k8 = (tid & 7) * 8;
        const float* tp = tile + j * TS + k8 * 65 + nn;
        u32x4 u;
        u.x = pack2(tp[0 * 65], tp[1 * 65]); u.y = pack2(tp[2 * 65], tp[3 * 65]);
        u.z = pack2(tp[4 * 65], tp[5 * 65]); u.w = pack2(tp[6 * 65], tp[7 * 65]);
        *(u32x4*)(dst + (size_t)(nt * 64 + nn) * K + kt * 64 + k8) = u;
      }
    }
  }
}

DI int t5_bucket(int rel) {
  int ret = rel > 0 ? 16 : 0;
  int n = rel < 0 ? -rel : rel;
  int b;
  if (n < 8) b = n;
  else { int lg = 31 - __clz(n * n); b = 8 + lg - 6; if (b > 15) b = 15; }
  return ret + b;
}

DI void phase_prep(const Params& p, char* smem) {
  float* tile = (float*)smem;
  char* ws = p.ws;
  for (int i = 0; i < 2; ++i) {
    prep_wt(p.ab_w_in + (size_t)i * 1024 * 2208, (u16*)(ws + W_ABIN) + (size_t)i * 2304 * 1024, 1024, 2208, 2304, p.norm_attn + (2 * i) * 1024, tile);
    prep_wt(p.ab_w_uq + (size_t)i * 384 * 768, (u16*)(ws + W_UQ) + (size_t)i * 768 * 384, 384, 768, 768, p.ab_q_norm + i * 384, tile);
    prep_wt(p.ab_w_ukv + (size_t)i * 256 * 1024, (u16*)(ws + W_UKV) + (size_t)i * 1024 * 256, 256, 1024, 1024, p.ab_kv_norm + i * 256, tile);
    prep_wt(p.ab_w_out + (size_t)i * 1024 * 1024, (u16*)(ws + W_ABOUT) + (size_t)i * 1024 * 1024, 1024, 1024, 1024, nullptr, tile);
    prep_wt(p.c_w_in + (size_t)i * 1024 * 3072, (u16*)(ws + W_CIN) + (size_t)i * 3072 * 1024, 1024, 3072, 3072, p.norm_attn + (2 * i + 1) * 1024, tile);
    prep_wt(p.c_w_out + (size_t)i * 1024 * 1024, (u16*)(ws + W_COUT) + (size_t)i * 1024 * 1024, 1024, 1024, 1024, nullptr, tile);
  }
  for (int i = 0; i < 4; ++i) {
    prep_wt(p.mlp_w1 + (size_t)i * 1024 * 4096, (u16*)(ws + W_W1) + (size_t)i * 4096 * 1024, 1024, 4096, 4096, p.norm_mlp + i * 1024, tile);
    prep_wt(p.mlp_w2 + (size_t)i * 4096 * 1024, (u16*)(ws + W_W2) + (size_t)i * 1024 * 4096, 4096, 1024, 1024, nullptr, tile);
  }
  {
    const int t0 = get_tid(); const int wave = t0 >> 6, lane = t0 & 63;
    u16* xb = (u16*)(ws + B_XR); float* ssa = (float*)(ws + TB_SSA);
    for (int row = blockIdx.x * 8 + wave; row < T_; row += gridDim.x * 8) {
      const f32x4* xr = (const f32x4*)(p.x + (size_t)row * 1024);
      float ss = 0.f;
#pragma unroll
      for (int i = 0; i < 2; ++i) {
        const f32x4 a = xr[2 * lane + 128 * i], b = xr[2 * lane + 128 * i + 1];
        ss += a[0] * a[0] + a[1] * a[1] + a[2] * a[2] + a[3] * a[3] + b[0] * b[0] + b[1] * b[1] + b[2] * b[2] + b[3] * b[3];
        st_bf8(xb + (size_t)row * 1024 + 8 * lane + 512 * i, a, b, 1.f);
      }
      ss = wave_sum(ss, lane);
      if (lane < 16) ssa[(size_t)row * 16 + lane] = (lane == 0) ? ss : 0.f;
    }
  }
  const int gt = blockIdx.x * NTHR + get_tid(), gn = gridDim.x * NTHR;
  float* tcos = (float*)(ws + TB_COS); float* tsin = (float*)(ws + TB_SIN);
  for (int idx = gt; idx < 4096 * 16; idx += gn) {
    int pos = idx >> 4, j = idx & 15;
    float inv = exp2f(-(float)j * (13.287712379549449f / 16.0f));
    float ang = (float)pos * inv;
    tcos[idx] = cosf(ang);
    tsin[idx] = sinf(ang);
  }
  float* t5t = (float*)(ws + TB_T5);
  for (int idx = gt; idx < 8 * 512; idx += gn) {
    int h = idx >> 9, e = idx & 511; int rel = e - 255; if (rel > 255) rel = 255;
    t5t[idx] = p.t5[t5_bucket(rel) * 8 + h] * LOG2E;
  }
  if (gt < 2) {
    float s1 = 0.f, s2 = 0.f;
    for (int d = 0; d < 64; ++d) { s1 += p.lq1[gt * 64 + d] * p.lk1[gt * 64 + d]; s2 += p.lq2[gt * 64 + d] * p.lk2[gt * 64 + d]; }
    int layer = 2 * gt + 1;
    float li = 0.8f - 0.6f * expf(-0.3f * (float)layer);
    ((float*)(ws + TB_LAM))[gt] = expf(s1) - expf(s2) + li;
  }
}

template <bool FINAL, bool IN_BF16>
DI void phase_norm(const void* __restrict__ xin, const float* __restrict__ g, u16* __restrict__ h, float* __restrict__ outf) {
  const int tid = get_tid();
  const int wave = tid >> 6, lane = tid & 63;
  for (int row = blockIdx.x * 8 + wave; row < T_; row += gridDim.x * 8) {
    f32x4 v[4]; float ss = 0.f;
    if (IN_BF16) {
      const u32x4* xr = (const u32x4*)((const u16*)xin + (size_t)row * 1024);
#pragma unroll
      for (int i = 0; i < 2; ++i) {
        const u32x4 u = xr[lane + 64 * i];
        v[2 * i]     = (f32x4){bf2f(u.x & 0xffffu), bf2f(u.x >> 16), bf2f(u.y & 0xffffu), bf2f(u.y >> 16)};
        v[2 * i + 1] = (f32x4){bf2f(u.z & 0xffffu), bf2f(u.z >> 16), bf2f(u.w & 0xffffu), bf2f(u.w >> 16)};
      }
    } else {
      const f32x4* xr = (const f32x4*)((const float*)xin + (size_t)row * 1024);
#pragma unroll
      for (int i = 0; i < 2; ++i) { v[2 * i] = xr[2 * lane + 128 * i]; v[2 * i + 1] = xr[2 * lane + 128 * i + 1]; }
    }
#pragma unroll
    for (int i = 0; i < 4; ++i) ss += v[i][0] * v[i][0] + v[i][1] * v[i][1] + v[i][2] * v[i][2] + v[i][3] * v[i][3];
    ss = wave_sum(ss, lane);
    const float rinv = rsqrtf(ss * (1.f / 1024.f) + EPS);
#pragma unroll
    for (int i = 0; i < 2; ++i) {
      const f32x4 g0 = ((const f32x4*)g)[2 * lane + 128 * i], g1 = ((const f32x4*)g)[2 * lane + 128 * i + 1];
      const f32x4 a = v[2 * i] * g0 * rinv, b = v[2 * i + 1] * g1 * rinv;
      if (FINAL) {
        f32x4* op = (f32x4*)(outf + (size_t)row * 1024);
        op[2 * lane + 128 * i] = a; op[2 * lane + 128 * i + 1] = b;
      } else {
        st_bf8(h + (size_t)row * 1024 + 8 * lane + 512 * i, a, b, 1.f);
      }
    }
  }
}

constexpr int SM_ATT_V = 17408;
constexpr int SM_ATT_TAB = 17408 + 64 * 320;
constexpr int STAGE_LDS = 131072;
constexpr int SM_RINVTAB = STAGE_LDS;
constexpr int ATT_LDS = 2 * (128 * 272 + 128 * 320) + 2048;
constexpr int SM_BARST = ATT_LDS;
constexpr int SMEM_BYTES = ATT_LDS + 16;
static_assert(ATT_LDS >= STAGE_LDS + 4096, "LDS map");
constexpr int ATT_HALF = 45056;
#define LAS __attribute__((address_space(3)))

namespace pg8 {
constexpr int BM = 256, BK = 64, HALF = 128, HTB = HALF * BK * 2, NXCD = 8, WGM = 8;
DI int lds_byte(int r, int c) { const int st = (r >> 4) * 2 + (c >> 5), rr = r & 15, cc = c & 31, ob = rr * 64 + cc * 2; return st * 1024 + (ob ^ (((ob >> 9) & 1) << 5)); }
DI void stage_rc(int b, int& R, int& C) { const int st = b / 1024, sb = b % 1024, swz = sb ^ (((sb >> 9) & 1) << 5); R = (st >> 1) * 16 + swz / 64; C = (st & 1) * 32 + (swz % 64) / 2; }
DI int perm32(int rho) { const int n = rho >> 4, i = rho & 15; return 8 * (i >> 2) + 4 * n + (i & 3); }
struct Unit { int pm, pn; };
struct Gemm { const u16* A; const u16* Bt; int M, N, K; };
struct StaticOrder {
  int nM, nN, nwg, G, c, rev, revn;
  DI void init(int M, int N, int G_, int c_) { nM = M / BM; nN = N / BM; nwg = nM * nN; G = G_; c = c_; rev = 0; revn = 0; }
  DI bool next(int i, Unit& u) const {
    if ((long)i * G + c >= nwg) return false;
    const int ii = (rev && (nwg % G) == 0) ? (nwg / G - 1 - i) : i;
    const long L = (long)ii * G + c;
    int wgid = (int)L; { const int q = nwg / NXCD, r = nwg % NXCD, xcd = wgid % NXCD, off = wgid / NXCD; wgid = (xcd < r ? xcd * (q + 1) : r * (q + 1) + (xcd - r) * q) + off; }
    const int nig = WGM * nN, gid = wgid / nig, fm = gid * WGM, gsz = (nM - fm) < WGM ? (nM - fm) : WGM;
    u.pm = fm + ((wgid % nig) % gsz); u.pn = (wgid % nig) / gsz; if (revn) u.pn = nN - 1 - u.pn; return true;
  }
};

template <class Epi, class Sched>
DI void gemm_phase(LAS unsigned char* lds, const Gemm g, const Sched& S, const Epi& E) {
  const int tid = get_tid(), wid = __builtin_amdgcn_readfirstlane(tid >> 6), lane = tid & 63, wr = wid >> 2, wc = wid & 3, fr = lane & 15, fq = lane >> 4;
  const int K = g.K, nt = K / BK;
  unsigned voffA[2], voffB[2];
#pragma unroll
  for (int i = 0; i < 2; ++i) { int R, C; stage_rc(tid * 16 + i * 8192, R, C); const int Rb = Epi::PERM ? ((R & ~31) + perm32(R & 31)) : R;
    voffA[i] = (unsigned)(R * K + C) * 2u; voffB[i] = (unsigned)(Rb * K + C) * 2u; }
  const size_t kstep = (size_t)(BK * 2);
  const size_t hstep = (size_t)HALF * K * 2;
  const size_t tstep = 2 * hstep;
  const unsigned ldsw = (unsigned)wid * 1024u;
  const int aoff = lds_byte(wr * 64 + fr, fq * 8), boff = lds_byte(wc * 32 + fr, fq * 8);
#define PG8_SA(b, h) (((b) * 2 + (h)) * HTB)
#define PG8_SB(b, h) ((4 + (b) * 2 + (h)) * HTB)
#define PG8_STAGE(bufoff, gbase, voff) do { _Pragma("unroll") for (int _i = 0; _i < 2; ++_i) \
    __builtin_amdgcn_global_load_lds((const unsigned*)((const char*)(gbase) + (voff)[_i]), (LAS unsigned*)(lds + (bufoff) + ldsw + _i * 8192), 16, 0, 0); } while (0)
#define PG8_LDA(dst, b, h) do { _Pragma("unroll") for (int m = 0; m < 4; ++m) _Pragma("unroll") for (int k = 0; k < 2; ++k) dst[m][k] = *(const LAS bf16x8*)(lds + PG8_SA(b, h) + aoff + m * 2048 + k * 1024); } while (0)
#define PG8_LDB(dst, b, h) do { _Pragma("unroll") for (int n = 0; n < 2; ++n) _Pragma("unroll") for (int k = 0; k < 2; ++k) dst[n][k] = *(const LAS bf16x8*)(lds + PG8_SB(b, h) + boff + n * 2048 + k * 1024); } while (0)
#define PG8_MMA(ai, bj, At, Bt) do { __builtin_amdgcn_s_setprio(1); _Pragma("unroll") for (int m = 0; m < 4; ++m) _Pragma("unroll") for (int n = 0; n < 2; ++n) _Pragma("unroll") for (int k = 0; k < 2; ++k) \
    acc[ai][bj][m][n] = __builtin_amdgcn_mfma_f32_16x16x32_bf16(Bt[n][k], At[m][k], acc[ai][bj][m][n], 0, 0, 0); __builtin_amdgcn_s_setprio(0); } while (0)
#define PG8_WAIT_V(n) asm volatile("s_waitcnt vmcnt(" #n ")" ::: "memory")
#define PG8_WAIT_L(n) asm volatile("s_waitcnt lgkmcnt(" #n ")" ::: "memory")
#define PG8_BAR __builtin_amdgcn_s_barrier()
#define PG8_SCHED __builtin_amdgcn_sched_barrier(0)
  Unit cur, nxt; int ui = 0;
  if (!S.next(0, cur)) return;
  f32x4 acc[2][2][4][2];
#pragma unroll
  for (int a = 0; a < 2; ++a)
#pragma unroll
    for (int b = 0; b < 2; ++b)
#pragma unroll
      for (int m = 0; m < 4; ++m)
#pragma unroll
        for (int n = 0; n < 2; ++n) acc[a][b][m][n] = (f32x4){0.f, 0.f, 0.f, 0.f};
  bf16x8 At[4][2], B0[2][2], B1[2][2];
  const char* cA = (const char*)g.A + (size_t)cur.pm * tstep; const char* cB = (const char*)g.Bt + (size_t)cur.pn * tstep;
  PG8_STAGE(PG8_SB(0, 0), cB, voffB); PG8_STAGE(PG8_SA(0, 0), cA, voffA); PG8_STAGE(PG8_SB(0, 1), cB + hstep, voffB); PG8_STAGE(PG8_SA(0, 1), cA + hstep, voffA);
  if (wr == 1) PG8_BAR;
  PG8_WAIT_V(4); PG8_BAR;
  PG8_STAGE(PG8_SB(1, 0), cB + kstep, voffB); PG8_STAGE(PG8_SA(1, 0), cA + kstep, voffA); PG8_STAGE(PG8_SB(1, 1), cB + hstep + kstep, voffB);
  PG8_WAIT_V(6); PG8_BAR;
  for (;;) {
    const bool has_next = S.next(ui + 1, nxt);
    const char* nA = has_next ? (const char*)g.A + (size_t)nxt.pm * tstep : cA; const char* nB = has_next ? (const char*)g.Bt + (size_t)nxt.pn * tstep : cB;
#pragma unroll 1
    for (int t = 0; t < nt; t += 2) {
      const bool last = (t == nt - 2);
      const char* a1 = cA + (size_t)(t + 1) * kstep;
      const char* a2 = last ? nA : cA + (size_t)(t + 2) * kstep; const char* b2 = last ? nB : cB + (size_t)(t + 2) * kstep;
      const char* a3 = a2 + kstep; const char* b3 = b2 + kstep;
      PG8_LDB(B0, 0, 0); PG8_SCHED; PG8_LDA(At, 0, 0); PG8_STAGE(PG8_SA(1, 1), a1 + hstep, voffA);
      PG8_WAIT_L(8); PG8_BAR; PG8_WAIT_L(0); PG8_MMA(0, 0, At, B0); PG8_BAR; PG8_SCHED;
      PG8_LDB(B1, 0, 1); PG8_STAGE(PG8_SB(0, 0), b2, voffB);
      PG8_BAR; PG8_WAIT_L(0); PG8_MMA(0, 1, At, B1); PG8_BAR;
      PG8_LDA(At, 0, 1); PG8_STAGE(PG8_SA(0, 0), a2, voffA);
      PG8_BAR; PG8_WAIT_L(0); PG8_MMA(1, 0, At, B0); PG8_BAR; PG8_SCHED;
      PG8_STAGE(PG8_SB(0, 1), b2 + hstep, voffB);
      PG8_WAIT_V(6); PG8_BAR; PG8_MMA(1, 1, At, B1); PG8_BAR;
      PG8_LDB(B0, 1, 0); PG8_SCHED; PG8_LDA(At, 1, 0); PG8_STAGE(PG8_SA(0, 1), a2 + hstep, voffA);
      PG8_WAIT_L(8); PG8_BAR; PG8_WAIT_L(0); PG8_MMA(0, 0, At, B0); PG8_BAR; PG8_SCHED;
      PG8_LDB(B1, 1, 1); PG8_STAGE(PG8_SB(1, 0), b3, voffB);
      PG8_BAR; PG8_WAIT_L(0); PG8_MMA(0, 1, At, B1); PG8_BAR;
      PG8_LDA(At, 1, 1); PG8_STAGE(PG8_SA(1, 0), a3, voffA);
      PG8_BAR; PG8_WAIT_L(0); PG8_MMA(1, 0, At, B0); PG8_BAR; PG8_SCHED;
      PG8_STAGE(PG8_SB(1, 1), b3 + hstep, voffB);
      PG8_WAIT_V(6); PG8_BAR; PG8_MMA(1, 1, At, B1); PG8_BAR;
    }
    E(acc, cur, wr, wc, fr, fq);
    if (!has_next) break;
#pragma unroll
    for (int a = 0; a < 2; ++a)
#pragma unroll
      for (int b = 0; b < 2; ++b)
#pragma unroll
        for (int m = 0; m < 4; ++m)
#pragma unroll
          for (int n = 0; n < 2; ++n) acc[a][b][m][n] = (f32x4){0.f, 0.f, 0.f, 0.f};
    cur = nxt; cA = nA; cB = nB; ++ui;
  }
  PG8_WAIT_V(0);
  if (wr == 0) PG8_BAR;
  PG8_BAR;
#undef PG8_SA
#undef PG8_SB
#undef PG8_STAGE
#undef PG8_LDA
#undef PG8_LDB
#undef PG8_MMA
#undef PG8_WAIT_V
#undef PG8_WAIT_L
#undef PG8_BAR
#undef PG8_SCHED
}
}

DI void rope_perm(f32x4& a0, f32x4& a1, int fq, int lane, const float* tcos, const float* tsin, int pos) {
  f32x4 p0, p1;
#pragma unroll
  for (int e = 0; e < 4; ++e) { p0[e] = shx(a0[e], 32, lane); p1[e] = shx(a1[e], 32, lane); }
  const int jb = 8 * (fq & 1);
  const f32x4 c0 = *(const f32x4*)(tcos + pos * 16 + jb), c1 = *(const f32x4*)(tcos + pos * 16 + jb + 4);
  const f32x4 s0 = *(const f32x4*)(tsin + pos * 16 + jb), s1 = *(const f32x4*)(tsin + pos * 16 + jb + 4);
  if (fq < 2) { a0 = a0 * c0 - p0 * s0; a1 = a1 * c1 - p1 * s1; }
  else        { a0 = a0 * c0 + p0 * s0; a1 = a1 * c1 + p1 * s1; }
}
enum { EPI_ABIN = 0, EPI_UQ = 1, EPI_UKV = 2, EPI_CIN = 3, EPI_RESID = 4, EPI_RELU2 = 5 };

template <int EPI> struct Epi {
  static constexpr bool PERM = true, AFTER_DRAIN = false;
  char* big; const float* rsrc; float* rdst; const float* tcos; const float* tsin;
  const LAS float* rinv_tab;
  u16* xr; float* ss_out;
  mutable int round;
  DI void operator()(const f32x4 (&acc)[2][2][4][2], const pg8::Unit& u, int wr, int wc, int fr_, int fq_) const {
    const int t_ = get_tid();
    const int fr = t_ & 15, fq = (t_ >> 4) & 3;
    const int slot = round; round = round + 1;
#pragma unroll
    for (int ai = 0; ai < 2; ++ai)
#pragma unroll
      for (int m = 0; m < 4; ++m) {
        const int rl = ai * 128 + wr * 64 + m * 16 + fr;
        const int token = u.pm * 256 + rl;
        float rinv = 1.f;
        if (EPI != EPI_RESID) rinv = rinv_tab[slot * 256 + rl];
        float ssq = 0.f;
#pragma unroll
        for (int bj = 0; bj < 2; ++bj)
#pragma unroll
          for (int n = 0; n < 2; ++n) {
            const int fb = u.pn * 256 + bj * 128 + wc * 32 + n * 16;
            const int f = fb + 4 * fq;
            const f32x4 v = acc[ai][bj][m][n];
            if (EPI == EPI_ABIN) {
              if (n == 0) {
                const int gb = u.pn * 256 + bj * 128 + wc * 32; const int f8 = gb + 8 * fq;
                const f32x4 v1 = acc[ai][bj][m][1];
                if (gb < 384) st_bf8((u16*)(big + E_CQ) + (size_t)token * 384 + f8, v, v1, rinv);
                else if (gb < 640) st_bf8((u16*)(big + E_CKV) + (size_t)token * 256 + (f8 - 384), v, v1, rinv);
                else if (gb < 672) {
                  f32x4 a0 = v, a1 = v1;
                  rope_perm(a0, a1, fq, t_ & 63, tcos, tsin, token & (S_ - 1));
                  st_bf8((u16*)(big + E_KPE) + (size_t)token * 32 + 8 * fq, a0, a1, rinv);
                }
                else if (gb < 1184) st_bf8((u16*)(big + E_QNA) + (size_t)token * 512 + (f8 - 672), v, v1, rinv * (0.125f * LOG2E));
                else if (gb < 1696) st_bf8((u16*)(big + E_KNA) + (size_t)token * 512 + (f8 - 1184), v, v1, rinv);
                else if (gb < 2208) st_bf8((u16*)(big + E_VNAT) + (size_t)token * 512 + (f8 - 1696), v, v1, rinv);
              }
            } else if (EPI == EPI_UQ) {
              if (n == 0) {
                const float sc = rinv * (0.10206207261596575f * LOG2E);
                const int gb = u.pn * 256 + bj * 128 + wc * 32;
                const int hd = gb / 96; const int within = gb - hd * 96;
                f32x4 a0 = v, a1 = acc[ai][bj][m][1];
                if (within == 64) rope_perm(a0, a1, fq, t_ & 63, tcos, tsin, token & (S_ - 1));
                st_bf8((u16*)(big + E_QMLA) + (size_t)token * 768 + gb + 8 * fq, a0, a1, sc);
              }
            } else if (EPI == EPI_UKV) {
              if (n == 0) {
                const int gb = u.pn * 256 + bj * 128 + wc * 32;
                const int hd = gb >> 7, within = (gb & 127) + 8 * fq;
                const f32x4 v1 = acc[ai][bj][m][1];
                if (within < 64) st_bf8((u16*)(big + E_KNOPE) + (size_t)token * 512 + hd * 64 + within, v, v1, rinv);
                else st_bf8((u16*)(big + E_VMLAT) + (size_t)token * 512 + hd * 64 + (within - 64), v, v1, rinv);
              }
            } else if (EPI == EPI_CIN) {
              if (n == 0) {
                const int gb = u.pn * 256 + bj * 128 + wc * 32;
                const int f8 = gb + 8 * fq;
                const f32x4 v1 = acc[ai][bj][m][1];
                if (gb < 1024) st_bf8((u16*)(big + O_QD) + (size_t)token * 1024 + f8, v, v1, rinv * (0.125f * LOG2E));
                else if (gb < 2048) st_bf8((u16*)(big + O_KD) + (size_t)token * 1024 + (f8 - 1024), v, v1, rinv);
                else st_bf8((u16*)(big + O_VDT) + (size_t)token * 1024 + (f8 - 2048), v, v1, rinv);
              }
            } else if (EPI == EPI_RESID) {
              if (n == 0) {
                const int f8 = u.pn * 256 + bj * 128 + wc * 32 + 8 * fq;
                const f32x4 v1 = acc[ai][bj][m][1];
                f32x4 r0, r1;
                if (rsrc) {
                  r0 = *(const f32x4*)(rsrc + (size_t)token * 1024 + f8); r1 = *(const f32x4*)(rsrc + (size_t)token * 1024 + f8 + 4);
                } else {
                  const u32x4 xu = *(const u32x4*)(xr + (size_t)token * 1024 + f8);
                  r0 = (f32x4){bf2f(xu.x & 0xffffu), bf2f(xu.x >> 16), bf2f(xu.y & 0xffffu), bf2f(xu.y >> 16)};
                  r1 = (f32x4){bf2f(xu.z & 0xffffu), bf2f(xu.z >> 16), bf2f(xu.w & 0xffffu), bf2f(xu.w >> 16)};
                }
                r0 += v; r1 += v1;
                st_bf8(xr + (size_t)token * 1024 + f8, r0, r1, 1.f);
                ssq += r0[0] * r0[0] + r0[1] * r0[1] + r0[2] * r0[2] + r0[3] * r0[3] + r1[0] * r1[0] + r1[1] * r1[1] + r1[2] * r1[2] + r1[3] * r1[3];
              }
            } else {
              if (n == 0) {
                const f32x4 v1 = acc[ai][bj][m][1];
                u32x4 o4;
                { const float t0 = fmaxf(v[0], 0.f) * rinv, t1 = fmaxf(v[1], 0.f) * rinv, t2 = fmaxf(v[2], 0.f) * rinv, t3 = fmaxf(v[3], 0.f) * rinv;
                  o4.x = pack2(t0 * t0, t1 * t1); o4.y = pack2(t2 * t2, t3 * t3); }
                { const float t0 = fmaxf(v1[0], 0.f) * rinv, t1 = fmaxf(v1[1], 0.f) * rinv, t2 = fmaxf(v1[2], 0.f) * rinv, t3 = fmaxf(v1[3], 0.f) * rinv;
                  o4.z = pack2(t0 * t0, t1 * t1); o4.w = pack2(t2 * t2, t3 * t3); }
                *(u32x4*)((u16*)big + (size_t)token * 4096 + u.pn * 256 + bj * 128 + wc * 32 + 8 * fq) = o4;
              }
            }
          }
        if (EPI == EPI_RESID) {
          ssq += shx(ssq, 16, t_ & 63);
          ssq += shx(ssq, 32, t_ & 63);
          if (fq == 0) ss_out[(size_t)token * 16 + u.pn * 4 + wc] = ssq;
        }
      }
  }
};

DI void rinv_prepass(const u16* __restrict__ A, int K, const pg8::StaticOrder& S, LAS float* tab) {
  const int tid = get_tid();
  const int row = tid >> 1, half = tid & 1;
  pg8::Unit u;
  for (int i = 0; i < 4 && S.next(i, u); ++i) {
    const u16* pr = A + (size_t)(u.pm * 256 + row) * K + half * (K >> 1);
    float ss = 0.f;
    for (int c = 0; c < (K >> 1); c += 8) {
      u32x4 w = *(const u32x4*)(pr + c);
      float a;
      a = bf2f(w.x & 0xffffu); ss += a * a; a = bf2f(w.x >> 16); ss += a * a;
      a = bf2f(w.y & 0xffffu); ss += a * a; a = bf2f(w.y >> 16); ss += a * a;
      a = bf2f(w.z & 0xffffu); ss += a * a; a = bf2f(w.z >> 16); ss += a * a;
      a = bf2f(w.w & 0xffffu); ss += a * a; a = bf2f(w.w >> 16); ss += a * a;
    }
    ss += shx(ss, 1, tid & 63);
    if (!half) tab[i * 256 + row] = rsqrtf(ss / (float)K + EPS);
  }
  __syncthreads();
}

DI void norm_prepass(const float* __restrict__ ss, const pg8::StaticOrder& S, LAS float* tab) {
  const int tid = get_tid();
  const int row = tid >> 1, half = tid & 1;
  pg8::Unit u;
  for (int i = 0; i < 8 && S.next(i, u); ++i) {
    const f32x4* sp = (const f32x4*)(ss + (size_t)(u.pm * 256 + row) * 16 + half * 8);
    const f32x4 a = sp[0], b = sp[1];
    float t = a[0]; t += a[1]; t += a[2]; t += a[3]; t += b[0]; t += b[1]; t += b[2]; t += b[3];
    const float o = shx(t, 1, tid & 63);
    const float tot = half ? (o + t) : (t + o);
    if (!half) tab[i * 256 + row] = rsqrtf(tot * (1.f / 1024.f) + EPS);
  }
  __syncthreads();
}

template <int EPI>
DI void run_gemm(LAS unsigned char* lds, const u16* A, const u16* Bt, int N, int K, const Params& q, const float* rsrc,
                 const float* ss_in, float* ss_out) {
  pg8::Gemm g; g.A = A; g.Bt = Bt; g.M = T_; g.N = N; g.K = K;
  pg8::StaticOrder S; S.init(T_, N, gridDim.x, blockIdx.x);
  if (EPI == EPI_RESID && K == 4096) S.rev = 1;
  if (EPI == EPI_ABIN) S.revn = 1;
  Epi<EPI> E;
  E.big = q.ws + B_BIG; E.rsrc = rsrc; E.rdst = q.xres;
  E.tcos = (const float*)(q.ws + TB_COS); E.tsin = (const float*)(q.ws + TB_SIN);
  E.rinv_tab = (const LAS float*)(lds + SM_RINVTAB); E.round = 0;
  E.xr = (u16*)(q.ws + B_XR); E.ss_out = ss_out;
  if (EPI == EPI_UQ || EPI == EPI_UKV) rinv_prepass(A, K, S, (LAS float*)(lds + SM_RINVTAB));
  if (EPI == EPI_ABIN || EPI == EPI_CIN || EPI == EPI_RELU2) norm_prepass(ss_in, S, (LAS float*)(lds + SM_RINVTAB));
  pg8::gemm_phase(lds, g, S, E);
}

DI bool softmax_tile(f32x16& s0, f32x16& s1, float& m, float& l, float& alpha, bf16x8* pf, int lane, bool first, bool check) {
  if (first) {
    float mx = fmaxf(s0[0], s1[0]);
#pragma unroll
    for (int i = 1; i < 16; ++i) mx = fmaxf(mx, fmaxf(s0[i], s1[i]));
    mx = fmaxf(mx, shx(mx, 32, lane));
    m += mx;
#pragma unroll
    for (int i = 0; i < 16; ++i) { s0[i] -= mx; s1[i] -= mx; }
  }
  float sum = 0.f;
#pragma unroll
  for (int i = 0; i < 16; ++i) { s0[i] = __builtin_amdgcn_exp2f(s0[i]); sum += s0[i]; }
#pragma unroll
  for (int i = 0; i < 16; ++i) { s1[i] = __builtin_amdgcn_exp2f(s1[i]); sum += s1[i]; }
  l += sum;
  pf[0] = pack8(s0, 0); pf[1] = pack8(s0, 8); pf[2] = pack8(s1, 0); pf[3] = pack8(s1, 8);
  alpha = 1.f;
  if (!check) return false;
  const float rsum = sum + shx(sum, 32, lane);
  const bool trig = rsum > 65536.f;
  const bool resc = (__builtin_amdgcn_ballot_w64(trig) != 0ull);
  alpha = 1.f;
  if (resc) {
    const float d = trig ? (float)(__builtin_amdgcn_frexp_expf(rsum) - 7) : 0.f;
    alpha = __builtin_amdgcn_exp2f(-d);
    m += d; l *= alpha;
  }
  return resc;
}
DI int tr_base(int lane, int RS) {
  const int hh = lane >> 5, g1 = (lane >> 4) & 1, q = (lane >> 2) & 3, pp = lane & 3;
  return (4 * hh + q) * RS + (16 * g1 + 4 * pp) * 2;
}
DI bf16x8 ld_vfrag_tr(const char* vs, int vbase, int RS, int koff, int coff) {
  const char* a = vs + vbase + koff * RS + coff * 2;
  const s16x4 lo = __builtin_amdgcn_ds_read_tr16_b64_v4i16((LAS s16x4*)a);
  const s16x4 hi = __builtin_amdgcn_ds_read_tr16_b64_v4i16((LAS s16x4*)(a + 8 * RS));
  return __builtin_shufflevector(lo, hi, 0, 1, 2, 3, 4, 5, 6, 7);
}
DI bf16x8 ld_vfrag_s(const char* vs, int stride, int dvrow, int keyoff, int s, int hh) {
  const char* a = vs + dvrow * stride + (keyoff + 16 * s + 4 * hh) * 2;
  s16x4 lo = *(const s16x4*)a;
  s16x4 hi = *(const s16x4*)(a + 16);
  return __builtin_shufflevector(lo, hi, 0, 1, 2, 3, 4, 5, 6, 7);
}
DI void st_vt_s(char* vs, int stride, int dvrow, int part, u32x4 v) {
  char* a = vs + dvrow * stride + part * 16;
  *(u32x2*)a = (u32x2){v.x, v.y};
  *(u32x2*)(a + 8) = (u32x2){v.z, v.w};
}
DI bf16x8 ld_vfrag(const char* vs, int dvrow, int s, int hh) {
  const char* a = vs + dvrow * 136 + (16 * s + 4 * hh) * 2;
  s16x4 lo = *(const s16x4*)a;
  s16x4 hi = *(const s16x4*)(a + 16);
  return __builtin_shufflevector(lo, hi, 0, 1, 2, 3, 4, 5, 6, 7);
}
DI void st_vt(char* vs, int dvrow, int part, u32x4 v) {
  char* a = vs + dvrow * 136 + part * 16;
  *(u32x2*)a = (u32x2){v.x, v.y};
  *(u32x2*)(a + 8) = (u32x2){v.z, v.w};
}
DI void scale16(f32x16& o, float a) {
#pragma unroll
  for (int i = 0; i < 16; ++i) o[i] *= a;
}

DI void attn_mla_unit(const Params& p, int b, int h, int qb, char* smem, bool pre, int nh, bool has_next) {
  const int tid = get_tid(), lane = tid & 63, w = tid >> 6, r32 = lane & 31, hh = lane >> 5;
  char* big = p.ws + B_BIG;
  const u16* qmla = (const u16*)(big + E_QMLA);
  const u16* knope = (const u16*)(big + E_KNOPE);
  const u16* kpe = (const u16*)(big + E_KPE);
  const u16* vT = (const u16*)(big + E_VMLAT);
  u16* o = (u16*)(p.ws + B_H);
  constexpr int KR = 208, VR = 192;
  constexpr int STG = 128 * KR + 128 * VR;
  const int vbase = tr_base(lane, VR);
  const int qrow = b * S_ + qb * 256 + w * 32 + r32;
  bf16x8 qf[6];
#pragma unroll
  for (int s = 0; s < 6; ++s) qf[s] = *(const bf16x8*)(qmla + (size_t)qrow * 768 + h * 96 + s * 16 + hh * 8);
  f32x16 O0, O1;
#pragma unroll
  for (int i = 0; i < 16; ++i) { O0[i] = 0.f; O1[i] = 0.f; }
  float m = 0.f, l = 0.f;
  const int krow = tid >> 3, kpart = tid & 7;
  const int prow = tid >> 2, ppart = tid & 3;
  const int vrow = tid >> 3, vpart = tid & 7;
  const u16* gk = knope + (size_t)(b * S_ + krow) * 512 + h * 64 + kpart * 8;
  const u16* gp = kpe + (size_t)(b * S_ + prow) * 32 + ppart * 8;
  const u16* gv = vT + (size_t)(b * S_ + vrow) * 512 + h * 64 + vpart * 8;
  u32x4 rk[2], rp, rv[2];
  if (!pre) {
#pragma unroll
    for (int i = 0; i < 2; ++i) { rk[i] = *(const u32x4*)(gk + (size_t)i * 64 * 512); rv[i] = *(const u32x4*)(gv + (size_t)i * 64 * 512); }
    rp = *(const u32x4*)gp;
  }
  auto put_stage = [&](char* kb) {
    char* vb = kb + 128 * KR;
#pragma unroll
    for (int i = 0; i < 2; ++i) {
      *(u32x4*)(kb + (krow + 64 * i) * KR + kpart * 16) = rk[i];
      *(u32x4*)(vb + (vrow + 64 * i) * VR + vpart * 16) = rv[i];
    }
    *(u32x4*)(kb + prow * KR + 128 + ppart * 16) = rp;
  };
  auto get_stage = [&](int st) {
    const int k0 = st * 128;
#pragma unroll
    for (int i = 0; i < 2; ++i) { rk[i] = *(const u32x4*)(gk + (size_t)(k0 + i * 64) * 512); rv[i] = *(const u32x4*)(gv + (size_t)(k0 + i * 64) * 512); }
    rp = *(const u32x4*)(gp + (size_t)k0 * 32);
  };
  __syncthreads();
  if (!pre) put_stage(smem);
  __syncthreads();
  get_stage(1);
  for (int kt = 0; kt < 32; ++kt) {
    const char* ks = smem + (kt & 1) * STG; const char* vs = ks + 128 * KR;
#pragma unroll
    for (int sub = 0; sub < 2; ++sub) {
      f32x16 s0, s1;
#pragma unroll
      for (int i = 0; i < 16; ++i) { s0[i] = -m; s1[i] = -m; }
      {
        bf16x8 kf[12];
#pragma unroll
        for (int s = 0; s < 6; ++s) {
          kf[2 * s] = *(const bf16x8*)(ks + (sub * 64 + r32) * KR + (s * 16 + hh * 8) * 2);
          kf[2 * s + 1] = *(const bf16x8*)(ks + (sub * 64 + 32 + r32) * KR + (s * 16 + hh * 8) * 2);
        }
        __builtin_amdgcn_sched_barrier(0); __builtin_amdgcn_s_setprio(1);
#pragma unroll
        for (int s = 0; s < 6; ++s) { s0 = mfma32(kf[2 * s], qf[s], s0); s1 = mfma32(kf[2 * s + 1], qf[s], s1); }
      __builtin_amdgcn_s_setprio(0);
}
      float alpha; bf16x8 pf[4];
      const bool resc = softmax_tile(s0, s1, m, l, alpha, pf, lane, (kt == 0) && (sub == 0), (sub == 0) && ((kt & 3) == 0));
      {
        bf16x8 vf[8];
#pragma unroll
        for (int s = 0; s < 4; ++s) { vf[2 * s] = ld_vfrag_tr(vs, vbase, VR, sub * 64 + 16 * s, 0); vf[2 * s + 1] = ld_vfrag_tr(vs, vbase, VR, sub * 64 + 16 * s, 32); }
        __builtin_amdgcn_sched_barrier(0); __builtin_amdgcn_s_setprio(1);
#pragma unroll
        for (int s = 0; s < 4; ++s) { O0 = mfma32(vf[2 * s], pf[s], O0); O1 = mfma32(vf[2 * s + 1], pf[s], O1); }
      __builtin_amdgcn_s_setprio(0);
}
      if (resc) { scale16(O0, alpha); scale16(O1, alpha); }
    }
    if (kt + 1 < 32) put_stage(smem + ((kt + 1) & 1) * STG);
    else if (has_next) put_stage(smem);
    __syncthreads();
    if (kt + 2 < 32) get_stage(kt + 2);
    else if (kt == 30 && has_next) { gk += (nh - h) * 64; gv += (nh - h) * 64; get_stage(0); }
  }
  const float lt = l + shx(l, 32, lane);
  const float inv = 1.f / lt;
  u16* op = o + (size_t)qrow * 1024 + h * 64 + 4 * hh;
#pragma unroll
  for (int i4 = 0; i4 < 4; ++i4) {
    st_bf4(op + 8 * i4, (f32x4){O0[4 * i4], O0[4 * i4 + 1], O0[4 * i4 + 2], O0[4 * i4 + 3]}, inv);
    st_bf4(op + 32 + 8 * i4, (f32x4){O1[4 * i4], O1[4 * i4 + 1], O1[4 * i4 + 2], O1[4 * i4 + 3]}, inv);
  }
}

DI void attn_na_unit(const Params& p, int li, int b, int r, int hp, char* smem) {
  const int tid = get_tid() & 255, lane = tid & 63, w = tid >> 6, r32 = lane & 31, hh = lane >> 5;
  char* big = p.ws + B_BIG;
  const u16* qna = (const u16*)(big + E_QNA);
  const u16* kna = (const u16*)(big + E_KNA);
  const u16* vT = (const u16*)(big + E_VNAT);
  u16* o = (u16*)(p.ws + B_H);
  char* ks = smem; char* vs = smem + SM_ATT_V; float* tab = (float*)(smem + SM_ATT_TAB);
  constexpr int KR = 272, VR = 320;
  const int vbase = tr_base(lane, VR);
  const int qbk = w & 1, hs = w >> 1, head = 2 * hp + hs;
  const int wq = 32 * qbk + r32;
  const int qrow = b * S_ + r * 64 + wq;
  int cs = wq - 8; cs = cs < 0 ? 0 : (cs > 48 ? 48 : cs);
  int rs = r - 4; rs = rs < 0 ? 0 : (rs > 56 ? 56 : rs);
  __syncthreads();
  for (int idx = tid; idx < 2 * 465; idx += 256) {
    int hsel = idx >= 465 ? 1 : 0; int rem = idx - hsel * 465;
    tab[idx] = p.ab_rpb[((size_t)(li * 8 + 2 * hp + hsel)) * 465 + rem] * LOG2E;
  }
  bf16x8 qf[4];
#pragma unroll
  for (int s = 0; s < 4; ++s) qf[s] = *(const bf16x8*)(qna + (size_t)qrow * 512 + head * 64 + s * 16 + hh * 8);
  f32x16 O0, O1;
#pragma unroll
  for (int i = 0; i < 16; ++i) { O0[i] = 0.f; O1[i] = 0.f; }
  float m = 0.f, l = 0.f;
  const int krow = tid >> 4, kpart = tid & 15;
  const u16* gk = kna + (size_t)(b * S_ + rs * 64 + krow) * 512 + hp * 128 + kpart * 8;
  const u16* gv = vT + (size_t)(b * S_ + rs * 64 + krow) * 512 + hp * 128 + kpart * 8;
  u32x4 rk[4], rv[4];
#pragma unroll
  for (int i = 0; i < 4; ++i) { rk[i] = *(const u32x4*)(gk + (size_t)i * 16 * 512); rv[i] = *(const u32x4*)(gv + (size_t)i * 16 * 512); }
  for (int kt = 0; kt < 8; ++kt) {
    __syncthreads();
#pragma unroll
    for (int i = 0; i < 4; ++i) {
      *(u32x4*)(ks + (krow + 16 * i) * KR + kpart * 16) = rk[i];
      *(u32x4*)(vs + (krow + 16 * i) * VR + kpart * 16) = rv[i];
    }
    __syncthreads();
    if (kt + 1 < 8) {
      const int k0 = (kt + 1) * 64;
#pragma unroll
      for (int i = 0; i < 4; ++i) { rk[i] = *(const u32x4*)(gk + (size_t)(k0 + i * 16) * 512); rv[i] = *(const u32x4*)(gv + (size_t)(k0 + i * 16) * 512); }
    }
    f32x16 s0, s1;
#pragma unroll
    for (int i = 0; i < 16; ++i) { s0[i] = -m; s1[i] = -m; }
    {
      bf16x8 kf[8];
#pragma unroll
      for (int s = 0; s < 4; ++s) {
        kf[2 * s] = *(const bf16x8*)(ks + r32 * KR + (hs * 64 + s * 16 + hh * 8) * 2);
        kf[2 * s + 1] = *(const bf16x8*)(ks + (32 + r32) * KR + (hs * 64 + s * 16 + hh * 8) * 2);
      }
      __builtin_amdgcn_sched_barrier(0); __builtin_amdgcn_s_setprio(1);
#pragma unroll
      for (int s = 0; s < 4; ++s) { s0 = mfma32(kf[2 * s], qf[s], s0); s1 = mfma32(kf[2 * s + 1], qf[s], s1); }
    __builtin_amdgcn_s_setprio(0);
}
    const int drow = rs + kt - r + 7;
    const float* trow = tab + hs * 465 + drow * 31;
#pragma unroll
    for (int i = 0; i < 16; ++i) {
      const int kc0 = (i & 3) + 8 * (i >> 2) + 4 * hh;
      const int kc1 = kc0 + 32;
      const bool v0 = (unsigned)(kc0 - cs) < 16u;
      const bool v1 = (unsigned)(kc1 - cs) < 16u;
      const int d0 = v0 ? (kc0 - wq + 15) : 0;
      const int d1 = v1 ? (kc1 - wq + 15) : 0;
      const float b0 = trow[d0], b1 = trow[d1];
      s0[i] = v0 ? s0[i] + b0 : -1e30f;
      s1[i] = v1 ? s1[i] + b1 : -1e30f;
    }
    float alpha; bf16x8 pf[4];
    const bool resc = softmax_tile(s0, s1, m, l, alpha, pf, lane, kt == 0, true);
    {
      bf16x8 vf[8];
#pragma unroll
      for (int s = 0; s < 4; ++s) { vf[2 * s] = ld_vfrag_tr(vs, vbase, VR, 16 * s, hs * 64); vf[2 * s + 1] = ld_vfrag_tr(vs, vbase, VR, 16 * s, hs * 64 + 32); }
      __builtin_amdgcn_sched_barrier(0); __builtin_amdgcn_s_setprio(1);
#pragma unroll
      for (int s = 0; s < 4; ++s) { O0 = mfma32(vf[2 * s], pf[s], O0); O1 = mfma32(vf[2 * s + 1], pf[s], O1); }
    __builtin_amdgcn_s_setprio(0);
}
    if (resc) { scale16(O0, alpha); scale16(O1, alpha); }
  }
  const float lt = l + shx(l, 32, lane);
  const float inv = 1.f / lt;
  u16* op = o + (size_t)qrow * 1024 + 512 + head * 64 + 4 * hh;
#pragma unroll
  for (int i4 = 0; i4 < 4; ++i4) {
    st_bf4(op + 8 * i4, (f32x4){O0[4 * i4], O0[4 * i4 + 1], O0[4 * i4 + 2], O0[4 * i4 + 3]}, inv);
    st_bf4(op + 32 + 8 * i4, (f32x4){O1[4 * i4], O1[4 * i4 + 1], O1[4 * i4 + 2], O1[4 * i4 + 3]}, inv);
  }
}

DI void attn_diff_unit(const Params& p, int li, int b, int h, int qb, char* smem, bool pre, int nh, bool has_next) {
  const int tid = get_tid(), lane = tid & 63, w = tid >> 6, r32 = lane & 31, hh = lane >> 5;
  char* big = p.ws + B_BIG;
  const u16* qd = (const u16*)(big + O_QD);
  const u16* kd = (const u16*)(big + O_KD);
  const u16* vT = (const u16*)(big + O_VDT);
  u16* o = (u16*)(p.ws + B_H);
  constexpr int KR = 272, VR = 320;
  constexpr int STG = 128 * KR + 128 * VR;
  const int vbase = tr_base(lane, VR);
  float* tab = (float*)(smem + 2 * STG);
  const int rg = w & 3, map = w >> 2;
  const int qpos = qb * 128 + rg * 32 + r32;
  const int qrow = b * S_ + qpos;
  __syncthreads();
  const float* t5t = (const float*)(p.ws + TB_T5) + h * 512;
  if (tid < 512) tab[tid] = t5t[tid];
  const float cL = t5t[0], cR = t5t[510];
  bf16x8 qf[4];
#pragma unroll
  for (int s = 0; s < 4; ++s) qf[s] = *(const bf16x8*)(qd + (size_t)qrow * 1024 + h * 128 + map * 64 + s * 16 + hh * 8);
  f32x16 O[4];
#pragma unroll
  for (int j = 0; j < 4; ++j)
#pragma unroll
    for (int i = 0; i < 16; ++i) O[j][i] = 0.f;
  float m = 0.f, l = 0.f;
  const int krow = tid >> 4, kpart = tid & 15;
  const u16* gk = kd + (size_t)(b * S_ + krow) * 1024 + h * 128 + kpart * 8;
  const u16* gv = vT + (size_t)(b * S_ + krow) * 1024 + h * 128 + kpart * 8;
  u32x4 rk[4], rv[4];
  if (!pre) {
#pragma unroll
    for (int i = 0; i < 4; ++i) { rk[i] = *(const u32x4*)(gk + (size_t)i * 32 * 1024); rv[i] = *(const u32x4*)(gv + (size_t)i * 32 * 1024); }
  }
  auto put_stage = [&](char* kb) {
    char* vb = kb + 128 * KR;
#pragma unroll
    for (int i = 0; i < 4; ++i) {
      *(u32x4*)(kb + (krow + 32 * i) * KR + kpart * 16) = rk[i];
      *(u32x4*)(vb + (krow + 32 * i) * VR + kpart * 16) = rv[i];
    }
  };
  auto get_stage = [&](int st) {
    const int k0 = st * 128;
#pragma unroll
    for (int i = 0; i < 4; ++i) { rk[i] = *(const u32x4*)(gk + (size_t)(k0 + i * 32) * 1024); rv[i] = *(const u32x4*)(gv + (size_t)(k0 + i * 32) * 1024); }
  };
  if (!pre) put_stage(smem);
  __syncthreads();
  get_stage(1);
  for (int kt = 0; kt < 32; ++kt) {
    const char* ks = smem + (kt & 1) * STG; const char* vs = ks + 128 * KR;
#pragma unroll
    for (int sub = 0; sub < 2; ++sub) {
      const int kbase = kt * 128 + sub * 64;
      const int relmin = kbase - (qb * 128 + 127), relmax = kbase + 63 - qb * 128;
      const float cb = (relmin >= 128) ? cR : ((relmax <= -128) ? cL : 0.f);
      f32x16 s0, s1;
#pragma unroll
      for (int i = 0; i < 16; ++i) { s0[i] = cb - m; s1[i] = cb - m; }
      {
        bf16x8 kf[8];
#pragma unroll
        for (int s = 0; s < 4; ++s) {
          kf[2 * s] = *(const bf16x8*)(ks + (sub * 64 + r32) * KR + (map * 64 + s * 16 + hh * 8) * 2);
          kf[2 * s + 1] = *(const bf16x8*)(ks + (sub * 64 + 32 + r32) * KR + (map * 64 + s * 16 + hh * 8) * 2);
        }
        __builtin_amdgcn_sched_barrier(0); __builtin_amdgcn_s_setprio(1);
#pragma unroll
        for (int s = 0; s < 4; ++s) { s0 = mfma32(kf[2 * s], qf[s], s0); s1 = mfma32(kf[2 * s + 1], qf[s], s1); }
      __builtin_amdgcn_s_setprio(0);
}
      if (relmin < 128 && relmax > -128) {
        const int base = kbase - qpos + 255 + 4 * hh;
#pragma unroll
        for (int i = 0; i < 16; ++i) {
          int i0 = base + (i & 3) + 8 * (i >> 2);
          int i1 = i0 + 32;
          i0 = i0 < 0 ? 0 : (i0 > 510 ? 510 : i0);
          i1 = i1 < 0 ? 0 : (i1 > 510 ? 510 : i1);
          s0[i] += tab[i0]; s1[i] += tab[i1];
        }
      }
      float alpha; bf16x8 pf[4];
      const bool resc = softmax_tile(s0, s1, m, l, alpha, pf, lane, (kt == 0) && (sub == 0), (sub == 0) && ((kt & 3) == 0));
      {
        bf16x8 vf[2][4];
#pragma unroll
        for (int j = 0; j < 4; ++j) vf[0][j] = ld_vfrag_tr(vs, vbase, VR, sub * 64, j * 32);
#pragma unroll
        for (int s = 0; s < 4; ++s) {
          if (s < 3) {
#pragma unroll
            for (int j = 0; j < 4; ++j) vf[(s + 1) & 1][j] = ld_vfrag_tr(vs, vbase, VR, sub * 64 + 16 * (s + 1), j * 32);
          }
          __builtin_amdgcn_sched_barrier(0); __builtin_amdgcn_s_setprio(1);
#pragma unroll
          for (int j = 0; j < 4; ++j) O[j] = mfma32(vf[s & 1][j], pf[s], O[j]);
        __builtin_amdgcn_s_setprio(0);
}
      }
      if (resc) {
#pragma unroll
        for (int j = 0; j < 4; ++j) scale16(O[j], alpha);
      }
    }
    if (kt + 1 < 32) put_stage(smem + ((kt + 1) & 1) * STG);
    else if (has_next) put_stage(smem);
    __syncthreads();
    if (kt + 2 < 32) get_stage(kt + 2);
    else if (kt == 30 && has_next) { gk += (nh - h) * 128; gv += (nh - h) * 128; get_stage(0); }
  }
  const float lt = l + shx(l, 32, lane);
  const float inv = 1.f / lt;
  float* xch = (float*)(smem + STG);
  if (map == 1) {
#pragma unroll
    for (int j = 0; j < 4; ++j)
#pragma unroll
      for (int i = 0; i < 16; ++i) xch[(rg * 64 + j * 16 + i) * 64 + lane] = O[j][i] * inv;
  }
  __syncthreads();
  if (map == 0) {
    const float lam = ((const float*)(p.ws + TB_LAM))[li];
    const int layer = 2 * li + 1;
    const float linit = 0.8f - 0.6f * expf(-0.3f * (float)layer);
    float ss = 0.f;
#pragma unroll
    for (int j = 0; j < 4; ++j)
#pragma unroll
      for (int i = 0; i < 16; ++i) {
        float v = O[j][i] * inv - lam * xch[(rg * 64 + j * 16 + i) * 64 + lane];
        O[j][i] = v; ss += v * v;
      }
    ss += shx(ss, 32, lane);
    const float rinv = rsqrtf(ss * (1.f / 128.f) + EPS) * (1.f - linit);
    const float* sub = p.c_subln + li * 128;
    u16* op = o + (size_t)qrow * 1024 + h * 128 + 4 * hh;
#pragma unroll
    for (int j = 0; j < 4; ++j)
#pragma unroll
      for (int i4 = 0; i4 < 4; ++i4) {
        const int dv = j * 32 + 8 * i4 + 4 * hh;
        const f32x4 g4 = *(const f32x4*)(sub + dv);
        f32x4 v = {O[j][4 * i4] * g4[0], O[j][4 * i4 + 1] * g4[1], O[j][4 * i4 + 2] * g4[2], O[j][4 * i4 + 3] * g4[3]};
        st_bf4(op + j * 32 + 8 * i4, v, rinv);
      }
  }
}

#define XB_TMO      128
#define XB_XCNT(j)  (256  + 64 * (j))
#define XB_XSUB(j)  (1280 + 64 * (j))
#define XB_XGEN(j)  (2304 + 64 * (j))
#define XB_TOP      3328
#define XB_TOPGEN   3392
#define XCD_BAR_WORDS 3456
#define XB_SPIN_CAP (1u << 18)
DI unsigned xb_ld(unsigned* p)              { return __hip_atomic_load(p, __ATOMIC_RELAXED, __HIP_MEMORY_SCOPE_AGENT); }
DI unsigned xb_add(unsigned* p, unsigned v) { return __hip_atomic_fetch_add(p, v, __ATOMIC_RELAXED, __HIP_MEMORY_SCOPE_AGENT); }
DI unsigned xb_xcc_id() { return (unsigned)__builtin_amdgcn_s_getreg((3 << 11) | 20) & 0xFu; }
#define XB_SPIN(cond, bar) do { unsigned _sp = 0; while (cond) { __builtin_amdgcn_s_sleep(1); \
    if ((++_sp & 255u) == 0u) { if (xb_ld(&(bar)[XB_TMO])) break; if (_sp > XB_SPIN_CAP) { atomicAdd(&(bar)[XB_TMO], 1u); break; } } } } while (0)
struct XcdBarrier { unsigned* bar; unsigned x; volatile LAS unsigned* st; };
DI XcdBarrier xcd_barrier_post(unsigned* bar, volatile LAS unsigned* st) {
  XcdBarrier b; b.bar = bar; b.x = xb_xcc_id(); b.st = st;
  if (threadIdx.x == 0) (void)xb_add(&bar[XB_XCNT(b.x)], 1u);
  return b;
}
DI void xcd_barrier_complete(unsigned* bar, unsigned x, unsigned& nloc, unsigned& nx) {
  const unsigned G = gridDim.x * gridDim.y * gridDim.z;
  unsigned sum, cnt, mine, sp = 0u;
  for (;;) {
    sum = 0u; cnt = 0u; mine = 0u;
#pragma unroll
    for (unsigned j = 0; j < 16; ++j) { const unsigned c = xb_ld(&bar[XB_XCNT(j)]); sum += c; cnt += (c > 0u) ? 1u : 0u; mine = (j == x) ? c : mine; }
    if (sum == G) break;
    __builtin_amdgcn_s_sleep(1);
    if ((++sp & 255u) == 0u) { if (xb_ld(&bar[XB_TMO])) break; if (sp > XB_SPIN_CAP) { atomicAdd(&bar[XB_TMO], 1u); break; } }
  }
  nloc = mine > 0u ? mine : 1u; nx = cnt > 0u ? cnt : 1u;
}
DI void xcd_barrier(const XcdBarrier& b) {
  asm volatile("s_waitcnt vmcnt(0)" ::: "memory");
  __syncthreads();
  if (threadIdx.x == 0) {
    size_t zb = 0; asm volatile("" : "+s"(zb));
    unsigned* bar = b.bar + zb;
    __builtin_amdgcn_s_waitcnt(0);
    unsigned nloc = b.st[0], nx = b.st[1];
    if (nloc == 0u) { xcd_barrier_complete(bar, b.x, nloc, nx); b.st[0] = nloc; b.st[1] = nx; }
    const unsigned old = xb_add(&bar[XB_XSUB(b.x)], 1u);
    const unsigned gen = old / nloc;
    if (old + 1u == (gen + 1u) * nloc) {
      __builtin_amdgcn_fence(__ATOMIC_RELEASE, "agent");
      asm volatile("s_waitcnt vmcnt(0)" ::: "memory");
      const unsigned og = xb_add(&bar[XB_TOP], 1u);
      const unsigned tg = og / nx;
      if (og + 1u == (tg + 1u) * nx) xb_add(&bar[XB_TOPGEN], 1u);
      else XB_SPIN(xb_ld(&bar[XB_TOPGEN]) == tg, bar);
      __builtin_amdgcn_fence(__ATOMIC_ACQUIRE, "agent");
      xb_add(&bar[XB_XGEN(b.x)], 1u);
      asm volatile("s_waitcnt vmcnt(0)" ::: "memory");
    } else {
      XB_SPIN(xb_ld(&bar[XB_XGEN(b.x)]) == gen, bar);
      __builtin_amdgcn_fence(__ATOMIC_ACQUIRE, "agent");
      asm volatile("s_waitcnt vmcnt(0)" ::: "memory");
    }
  }
  __syncthreads();
}

#define LAUNDER(q)  Params q = p; { size_t zoff = 0; asm volatile("" : "+s"(zoff)); q.ws = p.ws + zoff; q.xres = p.xres + zoff; q.x = p.x + zoff; }
#define PH_BEGIN(n) if (ph_lo <= (n) && (n) < ph_hi) { LAUNDER(q); char* ws = q.ws; (void)ws;
#define PH_END(n)   if ((n) + 1 < ph_hi) { xcd_barrier(xb); } }

__global__ void __launch_bounds__(512) mega(Params p, int ph_lo, int ph_hi) {
  extern __shared__ __attribute__((aligned(16))) unsigned char lds_raw[];
  LAS unsigned char* lds = (LAS unsigned char*)lds_raw;
  char* smem = (char*)lds_raw;
  const int nx = gridDim.x >> 3, xcd = blockIdx.x & 7, jx = blockIdx.x >> 3;
  volatile LAS unsigned* bst = (volatile LAS unsigned*)(lds + SM_BARST);
  if (threadIdx.x < 2) bst[threadIdx.x] = 0u;
  __syncthreads();
  const XcdBarrier xb = xcd_barrier_post((unsigned*)(p.ws + TB_BAR), bst);

  if (ph_lo < 0) cg::this_grid().sync();
  PH_BEGIN(0) phase_prep(q, smem); PH_END(0)

#pragma unroll 1
  for (int L = 0; L < 4; ++L) {
    const int pb = 1 + 8 * L, li = L >> 1;
    const bool even = (L & 1) == 0;
    if (even) {
      PH_BEGIN(pb + 1)
        run_gemm<EPI_ABIN>(lds, (const u16*)(ws + B_XR), (const u16*)(ws + W_ABIN) + (size_t)li * 2304 * 1024, 2304, 1024, q, nullptr, (const float*)(ws + TB_SSA), nullptr);
      PH_END(pb + 1)
      PH_BEGIN(pb + 2)
        run_gemm<EPI_UQ>(lds, (const u16*)(ws + B_BIG + E_CQ), (const u16*)(ws + W_UQ) + (size_t)li * 768 * 384, 768, 384, q, nullptr, nullptr, nullptr);
        run_gemm<EPI_UKV>(lds, (const u16*)(ws + B_BIG + E_CKV), (const u16*)(ws + W_UKV) + (size_t)li * 1024 * 256, 1024, 256, q, nullptr, nullptr, nullptr);
      PH_END(pb + 2)
      PH_BEGIN(pb + 3)
        if (jx < nx) {
          const int half = get_tid() >> 8;
          char* sm = smem + half * ATT_HALF;
#pragma unroll 1
          for (int u = jx; u < 128; u += nx) attn_mla_unit(q, xcd, u >> 4, u & 15, smem, u != jx, (u + nx) >> 4, u + nx < 128);
#pragma unroll 1
          for (int up = jx; up < 128; up += nx) { const int u = 2 * up + half; attn_na_unit(q, li, xcd, u >> 2, u & 3, sm); }
        }
      PH_END(pb + 3)
    } else {
      PH_BEGIN(pb + 1)
        run_gemm<EPI_CIN>(lds, (const u16*)(ws + B_XR), (const u16*)(ws + W_CIN) + (size_t)li * 3072 * 1024, 3072, 1024, q, nullptr, (const float*)(ws + TB_SSA), nullptr);
      PH_END(pb + 1)
      PH_BEGIN(pb + 3)
        if (jx < nx) {
          const int half = get_tid() >> 8;
          char* sm = smem + half * ATT_HALF;
#pragma unroll 1
          for (int u = jx; u < 256; u += nx) attn_diff_unit(q, li, xcd, u >> 5, u & 31, smem, u != jx, (u + nx) >> 5, u + nx < 256);
        }
      PH_END(pb + 3)
    }
    PH_BEGIN(pb + 4)
      run_gemm<EPI_RESID>(lds, (const u16*)(ws + B_H), (const u16*)(ws + (even ? W_ABOUT : W_COUT)) + (size_t)li * 1024 * 1024, 1024, 1024, q, (L == 0) ? q.x : nullptr, nullptr, (float*)(ws + TB_SSM));
    PH_END(pb + 4)
    PH_BEGIN(pb + 6)
      run_gemm<EPI_RELU2>(lds, (const u16*)(ws + B_XR), (const u16*)(ws + W_W1) + (size_t)L * 4096 * 1024, 4096, 1024, q, nullptr, (const float*)(ws + TB_SSM), nullptr);
    PH_END(pb + 6)
    PH_BEGIN(pb + 7)
      run_gemm<EPI_RESID>(lds, (const u16*)(ws + B_BIG), (const u16*)(ws + W_W2) + (size_t)L * 1024 * 4096, 1024, 4096, q, nullptr, nullptr, (float*)(ws + TB_SSA));
    PH_END(pb + 7)
  }

  PH_BEGIN(NPH - 1) phase_norm<true, true>(ws + B_XR, q.final_norm, nullptr, q.xres); PH_END(NPH - 1)
}

extern "C" void kernel_launch(void* const* d_in, const int* in_sizes, int n_in, void* d_out, int out_size,
                              void* d_ws, size_t ws_size, hipStream_t stream) {
  if (ws_size < WS_NEED) { fprintf(stderr, "workspace too small: %zu < %zu\n", ws_size, WS_NEED); return; }
  Params p{};
  p.x = (const float*)d_in[0]; p.norm_attn = (const float*)d_in[1]; p.norm_mlp = (const float*)d_in[2];
  p.ab_w_in = (const float*)d_in[3]; p.ab_q_norm = (const float*)d_in[4]; p.ab_w_uq = (const float*)d_in[5];
  p.ab_kv_norm = (const float*)d_in[6]; p.ab_w_ukv = (const float*)d_in[7]; p.ab_rpb = (const float*)d_in[8];
  p.ab_w_out = (const float*)d_in[9]; p.c_w_in = (const float*)d_in[10]; p.lq1 = (const float*)d_in[11];
  p.lk1 = (const float*)d_in[12]; p.lq2 = (const float*)d_in[13]; p.lk2 = (const float*)d_in[14];
  p.c_subln = (const float*)d_in[15]; p.c_w_out = (const float*)d_in[16]; p.t5 = (const float*)d_in[17];
  p.mlp_w1 = (const float*)d_in[18]; p.mlp_w2 = (const float*)d_in[19]; p.final_norm = (const float*)d_in[20];
  p.xres = (float*)d_out; p.ws = (char*)d_ws;

  static int grid_blocks = 0;
  if (!grid_blocks) {
    int dev = 0, cus = 0, per_cu = 0;
    (void)hipGetDevice(&dev);
    (void)hipDeviceGetAttribute(&cus, hipDeviceAttributeMultiprocessorCount, dev);
    if (hipFuncSetAttribute((const void*)mega, hipFuncAttributeMaxDynamicSharedMemorySize, SMEM_BYTES) != hipSuccess) { fprintf(stderr, "hipFuncSetAttribute failed\n"); grid_blocks = -1; return; }
    (void)hipOccupancyMaxActiveBlocksPerMultiprocessor(&per_cu, mega, NTHR, SMEM_BYTES);
    (void)hipGetLastError();
    grid_blocks = cus;
  }
  if (grid_blocks < 0) return;
#if MULTI_LAUNCH
  for (int ph = 0; ph < NPH; ++ph) {
    if (ph >= 1 && ph < NPH - 1 && ((ph - 1) & 7) == 2 && ((((ph - 1) >> 3) & 1) == 1)) continue;
    hipLaunchKernelGGL(mega, dim3(grid_blocks), dim3(NTHR), SMEM_BYTES, stream, p, ph, ph + 1);
  }
#else
  (void)hipMemsetAsync((char*)d_ws + TB_BAR, 0, 16384, stream);
  int lo = 0, hi = NPH;
  void* args[] = {&p, &lo, &hi};
  hipError_t e = hipLaunchCooperativeKernel((void*)mega, dim3(grid_blocks), dim3(NTHR), args, SMEM_BYTES, stream);
  if (e != hipSuccess) fprintf(stderr, "cooperative launch failed: %s (grid %d)\n", hipGetErrorString(e), grid_blocks);
#endif
}
```

```cpp
#include <hip/hip_runtime.h>
#include <hip/hip_cooperative_groups.h>
#include <cstdio>
namespace cg = cooperative_groups;

typedef unsigned short u16;
using bf16x8 = __attribute__((ext_vector_type(8))) short;
using s16x4  = __attribute__((ext_vector_type(4))) short;
using f32x4  = __attribute__((ext_vector_type(4))) float;
using f32x16 = __attribute__((ext_vector_type(16))) float;
using u32x4  = __attribute__((ext_vector_type(4))) unsigned;
using u32x2  = __attribute__((ext_vector_type(2))) unsigned;
typedef __bf16 bf2_t __attribute__((ext_vector_type(2)));
typedef float  fl2_t __attribute__((ext_vector_type(2)));
#define DI __device__ __forceinline__

#ifndef MULTI_LAUNCH
#define MULTI_LAUNCH 0
#endif

constexpr int T_ = 32768;
constexpr int S_ = 4096;
constexpr float LOG2E = 1.4426950408889634f;
constexpr float EPS = 1e-6f;
constexpr int NPH = 34;
constexpr int NTHR = 512;

constexpr size_t W_ABIN  = 0;
constexpr size_t W_UQ    = W_ABIN  + 2ull * 2304 * 1024 * 2;
constexpr size_t W_UKV   = W_UQ    + 2ull * 768 * 384 * 2;
constexpr size_t W_ABOUT = W_UKV   + 2ull * 1024 * 256 * 2;
constexpr size_t W_CIN   = W_ABOUT + 2ull * 1024 * 1024 * 2;
constexpr size_t W_COUT  = W_CIN   + 2ull * 3072 * 1024 * 2;
constexpr size_t W_W1    = W_COUT  + 2ull * 1024 * 1024 * 2;
constexpr size_t W_W2    = W_W1    + 4ull * 4096 * 1024 * 2;
constexpr size_t TB_COS  = W_W2    + 4ull * 4096 * 1024 * 2;
constexpr size_t TB_SIN  = TB_COS  + 4096ull * 16 * 4;
constexpr size_t TB_T5   = TB_SIN  + 4096ull * 16 * 4;
constexpr size_t TB_LAM  = TB_T5   + 8ull * 512 * 4;
constexpr size_t TB_SSA  = TB_LAM  + 256;
constexpr size_t TB_SSM  = TB_SSA  + (size_t)T_ * 16 * 4;
constexpr size_t TB_BAR  = TB_SSM  + (size_t)T_ * 16 * 4;
constexpr size_t B_H     = TB_BAR  + 16384;
constexpr size_t B_BIG   = B_H     + (size_t)T_ * 1024 * 2;
constexpr size_t E_CQ    = 0;
constexpr size_t E_CKV   = E_CQ    + (size_t)T_ * 384 * 2;
constexpr size_t E_KPE   = E_CKV   + (size_t)T_ * 256 * 2;
constexpr size_t E_QNA   = E_KPE   + (size_t)T_ * 32 * 2;
constexpr size_t E_KNA   = E_QNA   + (size_t)T_ * 512 * 2;
constexpr size_t E_VNAT  = E_KNA   + (size_t)T_ * 512 * 2;
constexpr size_t E_QMLA  = E_VNAT  + (size_t)T_ * 512 * 2;
constexpr size_t E_KNOPE = E_QMLA  + (size_t)T_ * 768 * 2;
constexpr size_t E_VMLAT = E_KNOPE + (size_t)T_ * 512 * 2;
constexpr size_t E_END   = E_VMLAT + (size_t)T_ * 512 * 2;
static_assert(E_END <= (size_t)T_ * 4096 * 2, "even buffers exceed BIG");
constexpr size_t O_QD    = 0;
constexpr size_t O_KD    = O_QD + (size_t)T_ * 1024 * 2;
constexpr size_t O_VDT   = O_KD + (size_t)T_ * 1024 * 2;
constexpr size_t B_XR    = B_BIG + (size_t)T_ * 4096 * 2;
constexpr size_t WS_NEED = B_XR + (size_t)T_ * 1024 * 2;

struct Params {
  const float* x; const float* norm_attn; const float* norm_mlp; const float* ab_w_in; const float* ab_q_norm;
  const float* ab_w_uq; const float* ab_kv_norm; const float* ab_w_ukv; const float* ab_rpb; const float* ab_w_out;
  const float* c_w_in; const float* lq1; const float* lk1; const float* lq2; const float* lk2; const float* c_subln;
  const float* c_w_out; const float* t5; const float* mlp_w1; const float* mlp_w2; const float* final_norm;
  float* xres; char* ws;
};

DI unsigned pack2(float a, float b) {
  fl2_t f = {a, b};
  bf2_t r = __builtin_convertvector(f, bf2_t);
  return __builtin_bit_cast(unsigned, r);
}
DI u16 f2bf(float x) { unsigned u = __float_as_uint(x); u += 0x7fffu + ((u >> 16) & 1u); return (u16)(u >> 16); }
DI float bf2f(unsigned v) { return __uint_as_float(v << 16); }
DI void st_bf4(u16* p, f32x4 v, float sc) {
  u32x2 u; u.x = pack2(v[0] * sc, v[1] * sc); u.y = pack2(v[2] * sc, v[3] * sc);
  *(u32x2*)p = u;
}
DI void st_bf8(u16* p, f32x4 a, f32x4 b, float sc) {
  u32x4 u; u.x = pack2(a[0] * sc, a[1] * sc); u.y = pack2(a[2] * sc, a[3] * sc); u.z = pack2(b[0] * sc, b[1] * sc); u.w = pack2(b[2] * sc, b[3] * sc);
  *(u32x4*)p = u;
}
DI void st_T(u16* p, f32x4 v, float sc) {
#pragma unroll
  for (int i = 0; i < 4; ++i) p[(size_t)i * S_] = f2bf(v[i] * sc);
}
DI int get_tid() { int t = threadIdx.x; asm volatile("" : "+v"(t)); return t; }
DI float shx(float v, int mask, int lane) {
  return __int_as_float(__builtin_amdgcn_ds_bpermute((lane ^ mask) << 2, __float_as_int(v)));
}
DI float wave_sum(float v, int lane) {
#pragma unroll
  for (int o = 32; o > 0; o >>= 1) v += shx(v, o, lane);
  return v;
}
DI f32x16 mfma32(bf16x8 a, bf16x8 b, f32x16 c) { return __builtin_amdgcn_mfma_f32_32x32x16_bf16(a, b, c, 0, 0, 0); }
DI f32x4 mfma16(bf16x8 a, bf16x8 b, f32x4 c) { return __builtin_amdgcn_mfma_f32_16x16x32_bf16(a, b, c, 0, 0, 0); }
DI bf16x8 pack8(const f32x16& s, int o) {
  u32x4 u;
  u.x = pack2(s[o + 0], s[o + 1]); u.y = pack2(s[o + 2], s[o + 3]);
  u.z = pack2(s[o + 4], s[o + 5]); u.w = pack2(s[o + 6], s[o + 7]);
  return __builtin_bit_cast(bf16x8, u);
}

DI void prep_wt(const float* __restrict__ src, u16* __restrict__ dst, int K, int N, int Npad,
                const float* __restrict__ gain, float* tile) {
  const int tid = get_tid();
  const int tk = K / 64, tn = Npad / 64, nt4 = tk * tn;
  constexpr int TS = 64 * 65;
  for (int t0 = blockIdx.x; t0 < nt4; t0 += 4 * gridDim.x) {
    f32x4 v[4][2];
#pragma unroll
    for (int j = 0; j < 4; ++j) {
      const int t = t0 + j * gridDim.x;
      const int kt = t % tk, nt = t / tk;
#pragma unroll
      for (int i = 0; i < 2; ++i) {
        const int e = tid + NTHR * i; const int kk = e >> 4, n4 = (e & 15) * 4; const int n = nt * 64 + n4;
        v[j][i] = (f32x4){0.f, 0.f, 0.f, 0.f};
        if (t < nt4 && n < N) {
          v[j][i] = *(const f32x4*)(src + (size_t)(kt * 64 + kk) * N + n);
          if (gain) v[j][i] *= gain[kt * 64 + kk];
        }
      }
    }
    __syncthreads();
#pragma unroll
    for (int j = 0; j < 4; ++j)
#pragma unroll
      for (int i = 0; i < 2; ++i) {
        const int e = tid + NTHR * i; const int kk = e >> 4, n4 = (e & 15) * 4;
        float* tp = tile + j * TS + kk * 65 + n4;
        tp[0] = v[j][i][0]; tp[1] = v[j][i][1]; tp[2] = v[j][i][2]; tp[3] = v[j][i][3];
      }
    __syncthreads();
#pragma unroll
    for (int j = 0; j < 4; ++j) {
      const int t = t0 + j * gridDim.x;
      if (t < nt4) {
        const int kt = t % tk, nt = t / tk;
        const int nn = tid >> 3, k8 = (tid & 7) * 8;
        const float* tp = tile + j * TS + k8 * 65 + nn;
        u32x4 u;
        u.x = pack2(tp[0 * 65], tp[1 * 65]); u.y = pack2(tp[2 * 65], tp[3 * 65]);
        u.z = pack2(tp[4 * 65], tp[5 * 65]); u.w = pack2(tp[6 * 65], tp[7 * 65]);
        *(u32x4*)(dst + (size_t)(nt * 64 + nn) * K + kt * 64 + k8) = u;
      }
    }
  }
}

DI int t5_bucket(int rel) {
  int ret = rel > 0 ? 16 : 0;
  int n = rel < 0 ? -rel : rel;
  int b;
  if (n < 8) b = n;
  else { int lg = 31 - __clz(n * n); b = 8 + lg - 6; if (b > 15) b = 15; }
  return ret + b;
}

DI void phase_prep(const Params& p, char* smem) {
  float* tile = (float*)smem;
  char* ws = p.ws;
  for (int i = 0; i < 2; ++i) {
    prep_wt(p.ab_w_in + (size_t)i * 1024 * 2208, (u16*)(ws + W_ABIN) + (size_t)i * 2304 * 1024, 1024, 2208, 2304, p.norm_attn + (2 * i) * 1024, tile);
    prep_wt(p.ab_w_uq + (size_t)i * 384 * 768, (u16*)(ws + W_UQ) + (size_t)i * 768 * 384, 384, 768, 768, p.ab_q_norm + i * 384, tile);
    prep_wt(p.ab_w_ukv + (size_t)i * 256 * 1024, (u16*)(ws + W_UKV) + (size_t)i * 1024 * 256, 256, 1024, 1024, p.ab_kv_norm + i * 256, tile);
    prep_wt(p.ab_w_out + (size_t)i * 1024 * 1024, (u16*)(ws + W_ABOUT) + (size_t)i * 1024 * 1024, 1024, 1024, 1024, nullptr, tile);
    prep_wt(p.c_w_in + (size_t)i * 1024 * 3072, (u16*)(ws + W_CIN) + (size_t)i * 3072 * 1024, 1024, 3072, 3072, p.norm_attn + (2 * i + 1) * 1024, tile);
    prep_wt(p.c_w_out + (size_t)i * 1024 * 1024, (u16*)(ws + W_COUT) + (size_t)i * 1024 * 1024, 1024, 1024, 1024, nullptr, tile);
  }
  for (int i = 0; i < 4; ++i) {
    prep_wt(p.mlp_w1 + (size_t)i * 1024 * 4096, (u16*)(ws + W_W1) + (size_t)i * 4096 * 1024, 1024, 4096, 4096, p.norm_mlp + i * 1024, tile);
    prep_wt(p.mlp_w2 + (size_t)i * 4096 * 1024, (u16*)(ws + W_W2) + (size_t)i * 1024 * 4096, 4096, 1024, 1024, nullptr, tile);
  }
  {
    const int t0 = get_tid(); const int wave = t0 >> 6, lane = t0 & 63;
    u16* xb = (u16*)(ws + B_XR); float* ssa = (float*)(ws + TB_SSA);
    for (int row = blockIdx.x * 8 + wave; row < T_; row += gridDim.x * 8) {
      const f32x4* xr = (const f32x4*)(p.x + (size_t)row * 1024);
      float ss = 0.f;
#pragma unroll
      for (int i = 0; i < 2; ++i) {
        const f32x4 a = xr[2 * lane + 128 * i], b = xr[2 * lane + 128 * i + 1];
        ss += a[0] * a[0] + a[1] * a[1] + a[2] * a[2] + a[3] * a[3] + b[0] * b[0] + b[1] * b[1] + b[2] * b[2] + b[3] * b[3];
        st_bf8(xb + (size_t)row * 1024 + 8 * lane + 512 * i, a, b, 1.f);
      }
      ss = wave_sum(ss, lane);
      if (lane < 16) ssa[(size_t)row * 16 + lane] = (lane == 0) ? ss : 0.f;
    }
  }
  const int gt = blockIdx.x * NTHR + get_tid(), gn = gridDim.x * NTHR;
  float* tcos = (float*)(ws + TB_COS); float* tsin = (float*)(ws + TB_SIN);
  for (int idx = gt; idx < 4096 * 16; idx += gn) {
    int pos = idx >> 4, j = idx & 15;
    float inv = exp2f(-(float)j * (13.287712379549449f / 16.0f));
    float ang = (float)pos * inv;
    tcos[idx] = cosf(ang);
    tsin[idx] = sinf(ang);
  }
  float* t5t = (float*)(ws + TB_T5);
  for (int idx = gt; idx < 8 * 512; idx += gn) {
    int h = idx >> 9, e = idx & 511; int rel = e - 255; if (rel > 255) rel = 255;
    t5t[idx] = p.t5[t5_bucket(rel) * 8 + h] * LOG2E;
  }
  if (gt < 2) {
    float s1 = 0.f, s2 = 0.f;
    for (int d = 0; d < 64; ++d) { s1 += p.lq1[gt * 64 + d] * p.lk1[gt * 64 + d]; s2 += p.lq2[gt * 64 + d] * p.lk2[gt * 64 + d]; }
    int layer = 2 * gt + 1;
    float li = 0.8f - 0.6f * expf(-0.3f * (float)layer);
    ((float*)(ws + TB_LAM))[gt] = expf(s1) - expf(s2) + li;
  }
}

template <bool FINAL, bool IN_BF16>
DI void phase_norm(const void* __restrict__ xin, const float* __restrict__ g, u16* __restrict__ h, float* __restrict__ outf) {
  const int tid = get_tid();
  const int wave = tid >> 6, lane = tid & 63;
  for (int row = blockIdx.x * 8 + wave; row < T_; row += gridDim.x * 8) {
    f32x4 v[4]; float ss = 0.f;
    if (IN_BF16) {
      const u32x4* xr = (const u32x4*)((const u16*)xin + (size_t)row * 1024);
#pragma unroll
      for (int i = 0; i < 2; ++i) {
        const u32x4 u = xr[lane + 64 * i];
        v[2 * i]     = (f32x4){bf2f(u.x & 0xffffu), bf2f(u.x >> 16), bf2f(u.y & 0xffffu), bf2f(u.y >> 16)};
        v[2 * i + 1] = (f32x4){bf2f(u.z & 0xffffu), bf2f(u.z >> 16), bf2f(u.w & 0xffffu), bf2f(u.w >> 16)};
      }
    } else {
      const f32x4* xr = (const f32x4*)((const float*)xin + (size_t)row * 1024);
#pragma unroll
      for (int i = 0; i < 2; ++i) { v[2 * i] = xr[2 * lane + 128 * i]; v[2 * i + 1] = xr[2 * lane + 128 * i + 1]; }
    }
#pragma unroll
    for (int i = 0; i < 4; ++i) ss += v[i][0] * v[i][0] + v[i][1] * v[i][1] + v[i][2] * v[i][2] + v[i][3] * v[i][3];
    ss = wave_sum(ss, lane);
    const float rinv = rsqrtf(ss * (1.f / 1024.f) + EPS);
#pragma unroll
    for (int i = 0; i < 2; ++i) {
      const f32x4 g0 = ((const f32x4*)g)[2 * lane + 128 * i], g1 = ((const f32x4*)g)[2 * lane + 128 * i + 1];
      const f32x4 a = v[2 * i] * g0 * rinv, b = v[2 * i + 1] * g1 * rinv;
      if (FINAL) {
        f32x4* op = (f32x4*)(outf + (size_t)row * 1024);
        op[2 * lane + 128 * i] = a; op[2 * lane + 128 * i + 1] = b;
      } else {
        st_bf8(h + (size_t)row * 1024 + 8 * lane + 512 * i, a, b, 1.f);
      }
    }
  }
}

constexpr int SM_ATT_V = 17408;
constexpr int SM_ATT_TAB = 17408 + 64 * 320;
constexpr int STAGE_LDS = 131072;
constexpr int SM_RINVTAB = STAGE_LDS;
constexpr int ATT_LDS = 2 * (128 * 272 + 128 * 320) + 2048;
constexpr int SM_BARST = ATT_LDS;
constexpr int SMEM_BYTES = ATT_LDS + 16;
static_assert(ATT_LDS >= STAGE_LDS + 4096, "LDS map");
constexpr int ATT_HALF = 45056;
#define LAS __attribute__((address_space(3)))

namespace pg8 {
constexpr int BM = 256, BK = 64, HALF = 128, HTB = HALF * BK * 2, NXCD = 8, WGM = 8;
DI int lds_byte(int r, int c) { const int st = (r >> 4) * 2 + (c >> 5), rr = r & 15, cc = c & 31, ob = rr * 64 + cc * 2; return st * 1024 + (ob ^ (((ob >> 9) & 1) << 5)); }
DI void stage_rc(int b, int& R, int& C) { const int st = b / 1024, sb = b % 1024, swz = sb ^ (((sb >> 9) & 1) << 5); R = (st >> 1) * 16 + swz / 64; C = (st & 1) * 32 + (swz % 64) / 2; }
DI int perm32(int rho) { const int n = rho >> 4, i = rho & 15; return 8 * (i >> 2) + 4 * n + (i & 3); }
struct Unit { int pm, pn; };
struct Gemm { const u16* A; const u16* Bt; int M, N, K; };
struct StaticOrder {
  int nM, nN, nwg, G, c, rev, revn;
  DI void init(int M, int N, int G_, int c_) { nM = M / BM; nN = N / BM; nwg = nM * nN; G = G_; c = c_; rev = 0; revn = 0; }
  DI bool next(int i, Unit& u) const {
    if ((long)i * G + c >= nwg) return false;
    const int ii = rev ? ((nwg - c + G - 1) / G - 1 - i) : i;
    const long L = (long)ii * G + c;
    int wgid = (int)L; { const int q = nwg / NXCD, r = nwg % NXCD, xcd = wgid % NXCD, off = wgid / NXCD; wgid = (xcd < r ? xcd * (q + 1) : r * (q + 1) + (xcd - r) * q) + off; }
    const int nig = WGM * nN, gid = wgid / nig, fm = gid * WGM, gsz = (nM - fm) < WGM ? (nM - fm) : WGM;
    u.pm = fm + ((wgid % nig) % gsz); u.pn = (wgid % nig) / gsz; if (revn) u.pn = nN - 1 - u.pn; return true;
  }
};

template <class Epi, class Sched>
DI void gemm_phase(LAS unsigned char* lds, const Gemm g, const Sched& S, const Epi& E) {
  const int tid = get_tid(), wid = __builtin_amdgcn_readfirstlane(tid >> 6), lane = tid & 63, wr = wid >> 2, wc = wid & 3, fr = lane & 15, fq = lane >> 4;
  const int K = g.K, nt = K / BK;
  unsigned voffA[2], voffB[2];
#pragma unroll
  for (int i = 0; i < 2; ++i) { int R, C; stage_rc(tid * 16 + i * 8192, R, C); const int Rb = Epi::PERM ? ((R & ~31) + perm32(R & 31)) : R;
    voffA[i] = (unsigned)(R * K + C) * 2u; voffB[i] = (unsigned)(Rb * K + C) * 2u; }
  const size_t kstep = (size_t)(BK * 2);
  const size_t hstep = (size_t)HALF * K * 2;
  const size_t tstep = 2 * hstep;
  const unsigned ldsw = (unsigned)wid * 1024u;
  const int aoff = lds_byte(wr * 64 + fr, fq * 8), boff = lds_byte(wc * 32 + fr, fq * 8);
#define PG8_SA(b, h) (((b) * 2 + (h)) * HTB)
#define PG8_SB(b, h) ((4 + (b) * 2 + (h)) * HTB)
#define PG8_STAGE(bufoff, gbase, voff) do { _Pragma("unroll") for (int _i = 0; _i < 2; ++_i) \
    __builtin_amdgcn_global_load_lds((const unsigned*)((const char*)(gbase) + (voff)[_i]), (LAS unsigned*)(lds + (bufoff) + ldsw + _i * 8192), 16, 0, 0); } while (0)
#define PG8_LDA(dst, b, h) do { _Pragma("unroll") for (int m = 0; m < 4; ++m) _Pragma("unroll") for (int k = 0; k < 2; ++k) dst[m][k] = *(const LAS bf16x8*)(lds + PG8_SA(b, h) + aoff + m * 2048 + k * 1024); } while (0)
#define PG8_LDB(dst, b, h) do { _Pragma("unroll") for (int n = 0; n < 2; ++n) _Pragma("unroll") for (int k = 0; k < 2; ++k) dst[n][k] = *(const LAS bf16x8*)(lds + PG8_SB(b, h) + boff + n * 2048 + k * 1024); } while (0)
#define PG8_MMA(ai, bj, At, Bt) do { __builtin_amdgcn_s_setprio(1); _Pragma("unroll") for (int m = 0; m < 4; ++m) _Pragma("unroll") for (int n = 0; n < 2; ++n) _Pragma("unroll") for (int k = 0; k < 2; ++k) \
    acc[ai][bj][m][n] = __builtin_amdgcn_mfma_f32_16x16x32_bf16(Bt[n][k], At[m][k], acc[ai][bj][m][n], 0, 0, 0); __builtin_amdgcn_s_setprio(0); } while (0)
#define PG8_WAIT_V(n) asm volatile("s_waitcnt vmcnt(" #n ")" ::: "memory")
#define PG8_WAIT_L(n) asm volatile("s_waitcnt lgkmcnt(" #n ")" ::: "memory")
#define PG8_BAR __builtin_amdgcn_s_barrier()
#define PG8_SCHED __builtin_amdgcn_sched_barrier(0)
  Unit cur, nxt; int ui = 0;
  if (!S.next(0, cur)) return;
  f32x4 acc[2][2][4][2];
#pragma unroll
  for (int a = 0; a < 2; ++a)
#pragma unroll
    for (int b = 0; b < 2; ++b)
#pragma unroll
      for (int m = 0; m < 4; ++m)
#pragma unroll
        for (int n = 0; n < 2; ++n) acc[a][b][m][n] = (f32x4){0.f, 0.f, 0.f, 0.f};
  bf16x8 At[4][2], B0[2][2], B1[2][2];
  const char* cA = (const char*)g.A + (size_t)cur.pm * tstep; const char* cB = (const char*)g.Bt + (size_t)cur.pn * tstep;
  PG8_STAGE(PG8_SB(0, 0), cB, voffB); PG8_STAGE(PG8_SA(0, 0), cA, voffA); PG8_STAGE(PG8_SB(0, 1), cB + hstep, voffB); PG8_STAGE(PG8_SA(0, 1), cA + hstep, voffA);
  if (wr == 1) PG8_BAR;
  PG8_WAIT_V(4); PG8_BAR;
  PG8_STAGE(PG8_SB(1, 0), cB + kstep, voffB); PG8_STAGE(PG8_SA(1, 0), cA + kstep, voffA); PG8_STAGE(PG8_SB(1, 1), cB + hstep + kstep, voffB);
  PG8_WAIT_V(6); PG8_BAR;
  for (;;) {
    const bool has_next = S.next(ui + 1, nxt);
    const char* nA = has_next ? (const char*)g.A + (size_t)nxt.pm * tstep : cA; const char* nB = has_next ? (const char*)g.Bt + (size_t)nxt.pn * tstep : cB;
#pragma unroll 1
    for (int t = 0; t < nt; t += 2) {
      const bool last = (t == nt - 2);
      const char* a1 = cA + (size_t)(t + 1) * kstep;
      const char* a2 = last ? nA : cA + (size_t)(t + 2) * kstep; const char* b2 = last ? nB : cB + (size_t)(t + 2) * kstep;
      const char* a3 = a2 + kstep; const char* b3 = b2 + kstep;
      PG8_LDB(B0, 0, 0); PG8_SCHED; PG8_LDA(At, 0, 0); PG8_STAGE(PG8_SA(1, 1), a1 + hstep, voffA);
      PG8_WAIT_L(8); PG8_BAR; PG8_WAIT_L(0); PG8_MMA(0, 0, At, B0); PG8_BAR; PG8_SCHED;
      PG8_LDB(B1, 0, 1); PG8_STAGE(PG8_SB(0, 0), b2, voffB);
      PG8_BAR; PG8_WAIT_L(0); PG8_MMA(0, 1, At, B1); PG8_BAR;
      PG8_LDA(At, 0, 1); PG8_STAGE(PG8_SA(0, 0), a2, voffA);
      PG8_BAR; PG8_WAIT_L(0); PG8_MMA(1, 0, At, B0); PG8_BAR; PG8_SCHED;
      PG8_STAGE(PG8_SB(0, 1), b2 + hstep, voffB);
      PG8_WAIT_V(6); PG8_BAR; PG8_MMA(1, 1, At, B1); PG8_BAR;
      PG8_LDB(B0, 1, 0); PG8_SCHED; PG8_LDA(At, 1, 0); PG8_STAGE(PG8_SA(0, 1), a2 + hstep, voffA);
      PG8_WAIT_L(8); PG8_BAR; PG8_WAIT_L(0); PG8_MMA(0, 0, At, B0); PG8_BAR; PG8_SCHED;
      PG8_LDB(B1, 1, 1); PG8_STAGE(PG8_SB(1, 0), b3, voffB);
      PG8_BAR; PG8_WAIT_L(0); PG8_MMA(0, 1, At, B1); PG8_BAR;
      PG8_LDA(At, 1, 1); PG8_STAGE(PG8_SA(1, 0), a3, voffA);
      PG8_BAR; PG8_WAIT_L(0); PG8_MMA(1, 0, At, B0); PG8_BAR; PG8_SCHED;
      PG8_STAGE(PG8_SB(1, 1), b3 + hstep, voffB);
      PG8_WAIT_V(6); PG8_BAR; PG8_MMA(1, 1, At, B1); PG8_BAR;
    }
    E(acc, cur, wr, wc, fr, fq);
    if (!has_next) break;
#pragma unroll
    for (int a = 0; a < 2; ++a)
#pragma unroll
      for (int b = 0; b < 2; ++b)
#pragma unroll
        for (int m = 0; m < 4; ++m)
#pragma unroll
          for (int n = 0; n < 2; ++n) acc[a][b][m][n] = (f32x4){0.f, 0.f, 0.f, 0.f};
    cur = nxt; cA = nA; cB = nB; ++ui;
  }
  PG8_WAIT_V(0);
  if (wr == 0) PG8_BAR;
  PG8_BAR;
#undef PG8_SA
#undef PG8_SB
#undef PG8_STAGE
#undef PG8_LDA
#undef PG8_LDB
#undef PG8_MMA
#undef PG8_WAIT_V
#undef PG8_WAIT_L
#undef PG8_BAR
#undef PG8_SCHED
}
}

DI void rope_perm(f32x4& a0, f32x4& a1, int fq, int lane, const float* tcos, const float* tsin, int pos) {
  f32x4 p0, p1;
#pragma unroll
  for (int e = 0; e < 4; ++e) { p0[e] = shx(a0[e], 32, lane); p1[e] = shx(a1[e], 32, lane); }
  const int jb = 8 * (fq & 1);
  const f32x4 c0 = *(const f32x4*)(tcos + pos * 16 + jb), c1 = *(const f32x4*)(tcos + pos * 16 + jb + 4);
  const f32x4 s0 = *(const f32x4*)(tsin + pos * 16 + jb), s1 = *(const f32x4*)(tsin + pos * 16 + jb + 4);
  if (fq < 2) { a0 = a0 * c0 - p0 * s0; a1 = a1 * c1 - p1 * s1; }
  else        { a0 = a0 * c0 + p0 * s0; a1 = a1 * c1 + p1 * s1; }
}
enum { EPI_ABIN = 0, EPI_UQ = 1, EPI_UKV = 2, EPI_CIN = 3, EPI_RESID = 4, EPI_RELU2 = 5 };

template <int EPI> struct Epi {
  static constexpr bool PERM = true, AFTER_DRAIN = false;
  char* big; const float* rsrc; float* rdst; const float* tcos; const float* tsin;
  const LAS float* rinv_tab;
  u16* xr; float* ss_out;
  mutable int round;
  DI void operator()(const f32x4 (&acc)[2][2][4][2], const pg8::Unit& u, int wr, int wc, int fr_, int fq_) const {
    const int t_ = get_tid();
    const int fr = t_ & 15, fq = (t_ >> 4) & 3;
    const int slot = round; round = round + 1;
#pragma unroll
    for (int ai = 0; ai < 2; ++ai)
#pragma unroll
      for (int m = 0; m < 4; ++m) {
        const int rl = ai * 128 + wr * 64 + m * 16 + fr;
        const int token = u.pm * 256 + rl;
        float rinv = 1.f;
        if (EPI != EPI_RESID) rinv = rinv_tab[slot * 256 + rl];
        float ssq = 0.f;
#pragma unroll
        for (int bj = 0; bj < 2; ++bj)
#pragma unroll
          for (int n = 0; n < 2; ++n) {
            const int fb = u.pn * 256 + bj * 128 + wc * 32 + n * 16;
            const int f = fb + 4 * fq;
            const f32x4 v = acc[ai][bj][m][n];
            if (EPI == EPI_ABIN) {
              if (n == 0) {
                const int gb = u.pn * 256 + bj * 128 + wc * 32; const int f8 = gb + 8 * fq;
                const f32x4 v1 = acc[ai][bj][m][1];
                if (gb < 384) st_bf8((u16*)(big + E_CQ) + (size_t)token * 384 + f8, v, v1, rinv);
                else if (gb < 640) st_bf8((u16*)(big + E_CKV) + (size_t)token * 256 + (f8 - 384), v, v1, rinv);
                else if (gb < 672) {
                  f32x4 a0 = v, a1 = v1;
                  rope_perm(a0, a1, fq, t_ & 63, tcos, tsin, token & (S_ - 1));
                  st_bf8((u16*)(big + E_KPE) + (size_t)token * 32 + 8 * fq, a0, a1, rinv);
                }
                else if (gb < 1184) st_bf8((u16*)(big + E_QNA) + (size_t)token * 512 + (f8 - 672), v, v1, rinv * (0.125f * LOG2E));
                else if (gb < 1696) st_bf8((u16*)(big + E_KNA) + (size_t)token * 512 + (f8 - 1184), v, v1, rinv);
                else if (gb < 2208) st_bf8((u16*)(big + E_VNAT) + (size_t)token * 512 + (f8 - 1696), v, v1, rinv);
              }
            } else if (EPI == EPI_UQ) {
              if (n == 0) {
                const float sc = rinv * (0.10206207261596575f * LOG2E);
                const int gb = u.pn * 256 + bj * 128 + wc * 32;
                const int hd = gb / 96; const int within = gb - hd * 96;
                f32x4 a0 = v, a1 = acc[ai][bj][m][1];
                if (within == 64) rope_perm(a0, a1, fq, t_ & 63, tcos, tsin, token & (S_ - 1));
                st_bf8((u16*)(big + E_QMLA) + (size_t)token * 768 + gb + 8 * fq, a0, a1, sc);
              }
            } else if (EPI == EPI_UKV) {
              if (n == 0) {
                const int gb = u.pn * 256 + bj * 128 + wc * 32;
                const int hd = gb >> 7, within = (gb & 127) + 8 * fq;
                const f32x4 v1 = acc[ai][bj][m][1];
                if (within < 64) st_bf8((u16*)(big + E_KNOPE) + (size_t)token * 512 + hd * 64 + within, v, v1, rinv);
                else st_bf8((u16*)(big + E_VMLAT) + (size_t)token * 512 + hd * 64 + (within - 64), v, v1, rinv);
              }
            } else if (EPI == EPI_CIN) {
              if (n == 0) {
                const int gb = u.pn * 256 + bj * 128 + wc * 32;
                const int f8 = gb + 8 * fq;
                const f32x4 v1 = acc[ai][bj][m][1];
                if (gb < 1024) st_bf8((u16*)(big + O_QD) + (size_t)token * 1024 + f8, v, v1, rinv * (0.125f * LOG2E));
                else if (gb < 2048) st_bf8((u16*)(big + O_KD) + (size_t)token * 1024 + (f8 - 1024), v, v1, rinv);
                else st_bf8((u16*)(big + O_VDT) + (size_t)token * 1024 + (f8 - 2048), v, v1, rinv);
              }
            } else if (EPI == EPI_RESID) {
              if (n == 0) {
                const int f8 = u.pn * 256 + bj * 128 + wc * 32 + 8 * fq;
                const f32x4 v1 = acc[ai][bj][m][1];
                f32x4 r0, r1;
                if (rsrc) {
                  r0 = *(const f32x4*)(rsrc + (size_t)token * 1024 + f8); r1 = *(const f32x4*)(rsrc + (size_t)token * 1024 + f8 + 4);
                } else {
                  const u32x4 xu = *(const u32x4*)(xr + (size_t)token * 1024 + f8);
                  r0 = (f32x4){bf2f(xu.x & 0xffffu), bf2f(xu.x >> 16), bf2f(xu.y & 0xffffu), bf2f(xu.y >> 16)};
                  r1 = (f32x4){bf2f(xu.z & 0xffffu), bf2f(xu.z >> 16), bf2f(xu.w & 0xffffu), bf2f(xu.w >> 16)};
                }
                r0 += v; r1 += v1;
                st_bf8(xr + (size_t)token * 1024 + f8, r0, r1, 1.f);
                ssq += r0[0] * r0[0] + r0[1] * r0[1] + r0[2] * r0[2] + r0[3] * r0[3] + r1[0] * r1[0] + r1[1] * r1[1] + r1[2] * r1[2] + r1[3] * r1[3];
              }
            } else {
              if (n == 0) {
                const f32x4 v1 = acc[ai][bj][m][1];
                u32x4 o4;
                { const float t0 = fmaxf(v[0], 0.f) * rinv, t1 = fmaxf(v[1], 0.f) * rinv, t2 = fmaxf(v[2], 0.f) * rinv, t3 = fmaxf(v[3], 0.f) * rinv;
                  o4.x = pack2(t0 * t0, t1 * t1); o4.y = pack2(t2 * t2, t3 * t3); }
                { const float t0 = fmaxf(v1[0], 0.f) * rinv, t1 = fmaxf(v1[1], 0.f) * rinv, t2 = fmaxf(v1[2], 0.f) * rinv, t3 = fmaxf(v1[3], 0.f) * rinv;
                  o4.z = pack2(t0 * t0, t1 * t1); o4.w = pack2(t2 * t2, t3 * t3); }
                *(u32x4*)((u16*)big + (size_t)token * 4096 + u.pn * 256 + bj * 128 + wc * 32 + 8 * fq) = o4;
              }
            }
          }
        if (EPI == EPI_RESID) {
          ssq += shx(ssq, 16, t_ & 63);
          ssq += shx(ssq, 32, t_ & 63);
          if (fq == 0) ss_out[(size_t)token * 16 + u.pn * 4 + wc] = ssq;
        }
      }
  }
};

DI void rinv_prepass(const u16* __restrict__ A, int K, const pg8::StaticOrder& S, LAS float* tab) {
  const int tid = get_tid();
  const int row = tid >> 1, half = tid & 1;
  pg8::Unit u;
  for (int i = 0; i < 4 && S.next(i, u); ++i) {
    const u16* pr = A + (size_t)(u.pm * 256 + row) * K + half * (K >> 1);
    float ss = 0.f;
    for (int c = 0; c < (K >> 1); c += 8) {
      u32x4 w = *(const u32x4*)(pr + c);
      float a;
      a = bf2f(w.x & 0xffffu); ss += a * a; a = bf2f(w.x >> 16); ss += a * a;
      a = bf2f(w.y & 0xffffu); ss += a * a; a = bf2f(w.y >> 16); ss += a * a;
      a = bf2f(w.z & 0xffffu); ss += a * a; a = bf2f(w.z >> 16); ss += a * a;
      a = bf2f(w.w & 0xffffu); ss += a * a; a = bf2f(w.w >> 16); ss += a * a;
    }
    ss += shx(ss, 1, tid & 63);
    if (!half) tab[i * 256 + row] = rsqrtf(ss / (float)K + EPS);
  }
  __syncthreads();
}

DI void norm_prepass(const float* __restrict__ ss, const pg8::StaticOrder& S, LAS float* tab) {
  const int tid = get_tid();
  const int row = tid >> 1, half = tid & 1;
  pg8::Unit u;
  for (int i = 0; i < 8 && S.next(i, u); ++i) {
    const f32x4* sp = (const f32x4*)(ss + (size_t)(u.pm * 256 + row) * 16 + half * 8);
    const f32x4 a = sp[0], b = sp[1];
    float t = a[0]; t += a[1]; t += a[2]; t += a[3]; t += b[0]; t += b[1]; t += b[2]; t += b[3];
    const float o = shx(t, 1, tid & 63);
    const float tot = half ? (o + t) : (t + o);
    if (!half) tab[i * 256 + row] = rsqrtf(tot * (1.f / 1024.f) + EPS);
  }
  __syncthreads();
}

template <int EPI>
DI void run_gemm(LAS unsigned char* lds, const u16* A, const u16* Bt, int N, int K, const Params& q, const float* rsrc,
                 const float* ss_in, float* ss_out) {
  pg8::Gemm g; g.A = A; g.Bt = Bt; g.M = T_; g.N = N; g.K = K;
  pg8::StaticOrder S; S.init(T_, N, gridDim.x, blockIdx.x);
  if ((EPI == EPI_RESID && K == 4096) || EPI == EPI_UQ || EPI == EPI_UKV) S.rev = 1;
  if (EPI == EPI_ABIN) S.revn = 1;
  Epi<EPI> E;
  E.big = q.ws + B_BIG; E.rsrc = rsrc; E.rdst = q.xres;
  E.tcos = (const float*)(q.ws + TB_COS); E.tsin = (const float*)(q.ws + TB_SIN);
  E.rinv_tab = (const LAS float*)(lds + SM_RINVTAB); E.round = 0;
  E.xr = (u16*)(q.ws + B_XR); E.ss_out = ss_out;
  if (EPI == EPI_UQ || EPI == EPI_UKV) rinv_prepass(A, K, S, (LAS float*)(lds + SM_RINVTAB));
  if (EPI == EPI_ABIN || EPI == EPI_CIN || EPI == EPI_RELU2) norm_prepass(ss_in, S, (LAS float*)(lds + SM_RINVTAB));
  pg8::gemm_phase(lds, g, S, E);
}

DI bool softmax_tile(f32x16& s0, f32x16& s1, float& m, float& l, float& alpha, bf16x8* pf, int lane, bool first, bool check) {
  if (first) {
    float mx = fmaxf(s0[0], s1[0]);
#pragma unroll
    for (int i = 1; i < 16; ++i) mx = fmaxf(mx, fmaxf(s0[i], s1[i]));
    mx = fmaxf(mx, shx(mx, 32, lane));
    m += mx;
#pragma unroll
    for (int i = 0; i < 16; ++i) { s0[i] -= mx; s1[i] -= mx; }
  }
  float sum = 0.f;
#pragma unroll
  for (int i = 0; i < 16; ++i) { s0[i] = __builtin_amdgcn_exp2f(s0[i]); sum += s0[i]; }
#pragma unroll
  for (int i = 0; i < 16; ++i) { s1[i] = __builtin_amdgcn_exp2f(s1[i]); sum += s1[i]; }
  l += sum;
  pf[0] = pack8(s0, 0); pf[1] = pack8(s0, 8); pf[2] = pack8(s1, 0); pf[3] = pack8(s1, 8);
  alpha = 1.f;
  if (!check) return false;
  const float rsum = sum + shx(sum, 32, lane);
  const bool trig = rsum > 65536.f;
  const bool resc = (__builtin_amdgcn_ballot_w64(trig) != 0ull);
  alpha = 1.f;
  if (resc) {
    const float d = trig ? (float)(__builtin_amdgcn_frexp_expf(rsum) - 7) : 0.f;
    alpha = __builtin_amdgcn_exp2f(-d);
    m += d; l *= alpha;
  }
  return resc;
}
DI int tr_base(int lane, int RS) {
  const int hh = lane >> 5, g1 = (lane >> 4) & 1, q = (lane >> 2) & 3, pp = lane & 3;
  return (4 * hh + q) * RS + (16 * g1 + 4 * pp) * 2;
}
DI bf16x8 ld_vfrag_tr(const char* vs, int vbase, int RS, int koff, int coff) {
  const char* a = vs + vbase + koff * RS + coff * 2;
  const s16x4 lo = __builtin_amdgcn_ds_read_tr16_b64_v4i16((LAS s16x4*)a);
  const s16x4 hi = __builtin_amdgcn_ds_read_tr16_b64_v4i16((LAS s16x4*)(a + 8 * RS));
  return __builtin_shufflevector(lo, hi, 0, 1, 2, 3, 4, 5, 6, 7);
}
DI bf16x8 ld_vfrag_s(const char* vs, int stride, int dvrow, int keyoff, int s, int hh) {
  const char* a = vs + dvrow * stride + (keyoff + 16 * s + 4 * hh) * 2;
  s16x4 lo = *(const s16x4*)a;
  s16x4 hi = *(const s16x4*)(a + 16);
  return __builtin_shufflevector(lo, hi, 0, 1, 2, 3, 4, 5, 6, 7);
}
DI void st_vt_s(char* vs, int stride, int dvrow, int part, u32x4 v) {
  char* a = vs + dvrow * stride + part * 16;
  *(u32x2*)a = (u32x2){v.x, v.y};
  *(u32x2*)(a + 8) = (u32x2){v.z, v.w};
}
DI bf16x8 ld_vfrag(const char* vs, int dvrow, int s, int hh) {
  const char* a = vs + dvrow * 136 + (16 * s + 4 * hh) * 2;
  s16x4 lo = *(const s16x4*)a;
  s16x4 hi = *(const s16x4*)(a + 16);
  return __builtin_shufflevector(lo, hi, 0, 1, 2, 3, 4, 5, 6, 7);
}
DI void st_vt(char* vs, int dvrow, int part, u32x4 v) {
  char* a = vs + dvrow * 136 + part * 16;
  *(u32x2*)a = (u32x2){v.x, v.y};
  *(u32x2*)(a + 8) = (u32x2){v.z, v.w};
}
DI void scale16(f32x16& o, float a) {
#pragma unroll
  for (int i = 0; i < 16; ++i) o[i] *= a;
}

DI void attn_mla_unit(const Params& p, int b, int h, int qb, char* smem, bool pre, int nh, bool has_next) {
  const int tid = get_tid(), lane = tid & 63, w = tid >> 6, r32 = lane & 31, hh = lane >> 5;
  char* big = p.ws + B_BIG;
  const u16* qmla = (const u16*)(big + E_QMLA);
  const u16* knope = (const u16*)(big + E_KNOPE);
  const u16* kpe = (const u16*)(big + E_KPE);
  const u16* vT = (const u16*)(big + E_VMLAT);
  u16* o = (u16*)(p.ws + B_H);
  constexpr int KR = 208, VR = 192;
  constexpr int STG = 128 * KR + 128 * VR;
  const int vbase = tr_base(lane, VR);
  const int qrow = b * S_ + qb * 256 + w * 32 + r32;
  bf16x8 qf[6];
#pragma unroll
  for (int s = 0; s < 6; ++s) qf[s] = *(const bf16x8*)(qmla + (size_t)qrow * 768 + h * 96 + s * 16 + hh * 8);
  f32x16 O0, O1;
#pragma unroll
  for (int i = 0; i < 16; ++i) { O0[i] = 0.f; O1[i] = 0.f; }
  float m = 0.f, l = 0.f;
  const int krow = tid >> 3, kpart = tid & 7;
  const int prow = tid >> 2, ppart = tid & 3;
  const int vrow = tid >> 3, vpart = tid & 7;
  const u16* gk = knope + (size_t)(b * S_ + krow) * 512 + h * 64 + kpart * 8;
  const u16* gp = kpe + (size_t)(b * S_ + prow) * 32 + ppart * 8;
  const u16* gv = vT + (size_t)(b * S_ + vrow) * 512 + h * 64 + vpart * 8;
  u32x4 rk[2], rp, rv[2];
  if (!pre) {
#pragma unroll
    for (int i = 0; i < 2; ++i) { rk[i] = *(const u32x4*)(gk + (size_t)i * 64 * 512); rv[i] = *(const u32x4*)(gv + (size_t)i * 64 * 512); }
    rp = *(const u32x4*)gp;
  }
  auto put_stage = [&](char* kb) {
    char* vb = kb + 128 * KR;
#pragma unroll
    for (int i = 0; i < 2; ++i) {
      *(u32x4*)(kb + (krow + 64 * i) * KR + kpart * 16) = rk[i];
      *(u32x4*)(vb + (vrow + 64 * i) * VR + vpart * 16) = rv[i];
    }
    *(u32x4*)(kb + prow * KR + 128 + ppart * 16) = rp;
  };
  auto get_stage = [&](int st) {
    const int k0 = st * 128;
#pragma unroll
    for (int i = 0; i < 2; ++i) { rk[i] = *(const u32x4*)(gk + (size_t)(k0 + i * 64) * 512); rv[i] = *(const u32x4*)(gv + (size_t)(k0 + i * 64) * 512); }
    rp = *(const u32x4*)(gp + (size_t)k0 * 32);
  };
  __syncthreads();
  if (!pre) put_stage(smem);
  __syncthreads();
  get_stage(1);
  for (int kt = 0; kt < 32; ++kt) {
    const char* ks = smem + (kt & 1) * STG; const char* vs = ks + 128 * KR;
#pragma unroll
    for (int sub = 0; sub < 2; ++sub) {
      f32x16 s0, s1;
#pragma unroll
      for (int i = 0; i < 16; ++i) { s0[i] = -m; s1[i] = -m; }
      {
        bf16x8 kf[12];
#pragma unroll
        for (int s = 0; s < 6; ++s) {
          kf[2 * s] = *(const bf16x8*)(ks + (sub * 64 + r32) * KR + (s * 16 + hh * 8) * 2);
          kf[2 * s + 1] = *(const bf16x8*)(ks + (sub * 64 + 32 + r32) * KR + (s * 16 + hh * 8) * 2);
        }
        __builtin_amdgcn_sched_barrier(0); __builtin_amdgcn_s_setprio(1);
#pragma unroll
        for (int s = 0; s < 6; ++s) { s0 = mfma32(kf[2 * s], qf[s], s0); s1 = mfma32(kf[2 * s + 1], qf[s], s1); }
      __builtin_amdgcn_s_setprio(0);
}
      float alpha; bf16x8 pf[4];
      const bool resc = softmax_tile(s0, s1, m, l, alpha, pf, lane, (kt == 0) && (sub == 0), (sub == 0) && ((kt & 3) == 0));
      {
        bf16x8 vf[8];
#pragma unroll
        for (int s = 0; s < 4; ++s) { vf[2 * s] = ld_vfrag_tr(vs, vbase, VR, sub * 64 + 16 * s, 0); vf[2 * s + 1] = ld_vfrag_tr(vs, vbase, VR, sub * 64 + 16 * s, 32); }
        __builtin_amdgcn_sched_barrier(0); __builtin_amdgcn_s_setprio(1);
#pragma unroll
        for (int s = 0; s < 4; ++s) { O0 = mfma32(vf[2 * s], pf[s], O0); O1 = mfma32(vf[2 * s + 1], pf[s], O1); }
      __builtin_amdgcn_s_setprio(0);
}
      if (resc) { scale16(O0, alpha); scale16(O1, alpha); }
    }
    if (kt + 1 < 32) put_stage(smem + ((kt + 1) & 1) * STG);
    else if (has_next) put_stage(smem);
    __syncthreads();
    if (kt + 2 < 32) get_stage(kt + 2);
    else if (kt == 30 && has_next) { gk += (nh - h) * 64; gv += (nh - h) * 64; get_stage(0); }
  }
  const float lt = l + shx(l, 32, lane);
  const float inv = 1.f / lt;
  u16* op = o + (size_t)qrow * 1024 + h * 64 + 4 * hh;
#pragma unroll
  for (int i4 = 0; i4 < 4; ++i4) {
    st_bf4(op + 8 * i4, (f32x4){O0[4 * i4], O0[4 * i4 + 1], O0[4 * i4 + 2], O0[4 * i4 + 3]}, inv);
    st_bf4(op + 32 + 8 * i4, (f32x4){O1[4 * i4], O1[4 * i4 + 1], O1[4 * i4 + 2], O1[4 * i4 + 3]}, inv);
  }
}

DI void attn_na_unit(const Params& p, int li, int b, int r, int hp, char* smem) {
  const int tid = get_tid() & 255, lane = tid & 63, w = tid >> 6, r32 = lane & 31, hh = lane >> 5;
  char* big = p.ws + B_BIG;
  const u16* qna = (const u16*)(big + E_QNA);
  const u16* kna = (const u16*)(big + E_KNA);
  const u16* vT = (const u16*)(big + E_VNAT);
  u16* o = (u16*)(p.ws + B_H);
  char* ks = smem; char* vs = smem + SM_ATT_V; float* tab = (float*)(smem + SM_ATT_TAB);
  constexpr int KR = 272, VR = 320;
  const int vbase = tr_base(lane, VR);
  const int qbk = w & 1, hs = w >> 1, head = 2 * hp + hs;
  const int wq = 32 * qbk + r32;
  const int qrow = b * S_ + r * 64 + wq;
  int cs = wq - 8; cs = cs < 0 ? 0 : (cs > 48 ? 48 : cs);
  int rs = r - 4; rs = rs < 0 ? 0 : (rs > 56 ? 56 : rs);
  __syncthreads();
  for (int idx = tid; idx < 2 * 465; idx += 256) {
    int hsel = idx >= 465 ? 1 : 0; int rem = idx - hsel * 465;
    tab[idx] = p.ab_rpb[((size_t)(li * 8 + 2 * hp + hsel)) * 465 + rem] * LOG2E;
  }
  bf16x8 qf[4];
#pragma unroll
  for (int s = 0; s < 4; ++s) qf[s] = *(const bf16x8*)(qna + (size_t)qrow * 512 + head * 64 + s * 16 + hh * 8);
  f32x16 O0, O1;
#pragma unroll
  for (int i = 0; i < 16; ++i) { O0[i] = 0.f; O1[i] = 0.f; }
  float m = 0.f, l = 0.f;
  const int krow = tid >> 4, kpart = tid & 15;
  const u16* gk = kna + (size_t)(b * S_ + rs * 64 + krow) * 512 + hp * 128 + kpart * 8;
  const u16* gv = vT + (size_t)(b * S_ + rs * 64 + krow) * 512 + hp * 128 + kpart * 8;
  u32x4 rk[4], rv[4];
#pragma unroll
  for (int i = 0; i < 4; ++i) { rk[i] = *(const u32x4*)(gk + (size_t)i * 16 * 512); rv[i] = *(const u32x4*)(gv + (size_t)i * 16 * 512); }
  for (int kt = 0; kt < 8; ++kt) {
    __syncthreads();
#pragma unroll
    for (int i = 0; i < 4; ++i) {
      *(u32x4*)(ks + (krow + 16 * i) * KR + kpart * 16) = rk[i];
      *(u32x4*)(vs + (krow + 16 * i) * VR + kpart * 16) = rv[i];
    }
    __syncthreads();
    if (kt + 1 < 8) {
      const int k0 = (kt + 1) * 64;
#pragma unroll
      for (int i = 0; i < 4; ++i) { rk[i] = *(const u32x4*)(gk + (size_t)(k0 + i * 16) * 512); rv[i] = *(const u32x4*)(gv + (size_t)(k0 + i * 16) * 512); }
    }
    f32x16 s0, s1;
#pragma unroll
    for (int i = 0; i < 16; ++i) { s0[i] = -m; s1[i] = -m; }
    {
      bf16x8 kf[8];
#pragma unroll
      for (int s = 0; s < 4; ++s) {
        kf[2 * s] = *(const bf16x8*)(ks + r32 * KR + (hs * 64 + s * 16 + hh * 8) * 2);
        kf[2 * s + 1] = *(const bf16x8*)(ks + (32 + r32) * KR + (hs * 64 + s * 16 + hh * 8) * 2);
      }
      __builtin_amdgcn_sched_barrier(0); __builtin_amdgcn_s_setprio(1);
#pragma unroll
      for (int s = 0; s < 4; ++s) { s0 = mfma32(kf[2 * s], qf[s], s0); s1 = mfma32(kf[2 * s + 1], qf[s], s1); }
    __builtin_amdgcn_s_setprio(0);
}
    const int drow = rs + kt - r + 7;
    const float* trow = tab + hs * 465 + drow * 31;
#pragma unroll
    for (int i = 0; i < 16; ++i) {
      const int kc0 = (i & 3) + 8 * (i >> 2) + 4 * hh;
      const int kc1 = kc0 + 32;
      const bool v0 = (unsigned)(kc0 - cs) < 16u;
      const bool v1 = (unsigned)(kc1 - cs) < 16u;
      const int d0 = v0 ? (kc0 - wq + 15) : 0;
      const int d1 = v1 ? (kc1 - wq + 15) : 0;
      const float b0 = trow[d0], b1 = trow[d1];
      s0[i] = v0 ? s0[i] + b0 : -1e30f;
      s1[i] = v1 ? s1[i] + b1 : -1e30f;
    }
    float alpha; bf16x8 pf[4];
    const bool resc = softmax_tile(s0, s1, m, l, alpha, pf, lane, kt == 0, true);
    {
      bf16x8 vf[8];
#pragma unroll
      for (int s = 0; s < 4; ++s) { vf[2 * s] = ld_vfrag_tr(vs, vbase, VR, 16 * s, hs * 64); vf[2 * s + 1] = ld_vfrag_tr(vs, vbase, VR, 16 * s, hs * 64 + 32); }
      __builtin_amdgcn_sched_barrier(0); __builtin_amdgcn_s_setprio(1);
#pragma unroll
      for (int s = 0; s < 4; ++s) { O0 = mfma32(vf[2 * s], pf[s], O0); O1 = mfma32(vf[2 * s + 1], pf[s], O1); }
    __builtin_amdgcn_s_setprio(0);
}
    if (resc) { scale16(O0, alpha); scale16(O1, alpha); }
  }
  const float lt = l + shx(l, 32, lane);
  const float inv = 1.f / lt;
  u16* op = o + (size_t)qrow * 1024 + 512 + head * 64 + 4 * hh;
#pragma unroll
  for (int i4 = 0; i4 < 4; ++i4) {
    st_bf4(op + 8 * i4, (f32x4){O0[4 * i4], O0[4 * i4 + 1], O0[4 * i4 + 2], O0[4 * i4 + 3]}, inv);
    st_bf4(op + 32 + 8 * i4, (f32x4){O1[4 * i4], O1[4 * i4 + 1], O1[4 * i4 + 2], O1[4 * i4 + 3]}, inv);
  }
}

DI void attn_diff_unit(const Params& p, int li, int b, int h, int qb, char* smem, bool pre, int nh, bool has_next) {
  const int tid = get_tid(), lane = tid & 63, w = tid >> 6, r32 = lane & 31, hh = lane >> 5;
  char* big = p.ws + B_BIG;
  const u16* qd = (const u16*)(big + O_QD);
  const u16* kd = (const u16*)(big + O_KD);
  const u16* vT = (const u16*)(big + O_VDT);
  u16* o = (u16*)(p.ws + B_H);
  constexpr int KR = 272, VR = 320;
  constexpr int STG = 128 * KR + 128 * VR;
  const int vbase = tr_base(lane, VR);
  float* tab = (float*)(smem + 2 * STG);
  const int rg = w & 3, map = w >> 2;
  const int qpos = qb * 128 + rg * 32 + r32;
  const int qrow = b * S_ + qpos;
  __syncthreads();
  const float* t5t = (const float*)(p.ws + TB_T5) + h * 512;
  if (tid < 512) tab[tid] = t5t[tid];
  const float cL = t5t[0], cR = t5t[510];
  bf16x8 qf[4];
#pragma unroll
  for (int s = 0; s < 4; ++s) qf[s] = *(const bf16x8*)(qd + (size_t)qrow * 1024 + h * 128 + map * 64 + s * 16 + hh * 8);
  f32x16 O[4];
#pragma unroll
  for (int j = 0; j < 4; ++j)
#pragma unroll
    for (int i = 0; i < 16; ++i) O[j][i] = 0.f;
  float m = 0.f, l = 0.f;
  const int krow = tid >> 4, kpart = tid & 15;
  const u16* gk = kd + (size_t)(b * S_ + krow) * 1024 + h * 128 + kpart * 8;
  const u16* gv = vT + (size_t)(b * S_ + krow) * 1024 + h * 128 + kpart * 8;
  u32x4 rk[4], rv[4];
  if (!pre) {
#pragma unroll
    for (int i = 0; i < 4; ++i) { rk[i] = *(const u32x4*)(gk + (size_t)i * 32 * 1024); rv[i] = *(const u32x4*)(gv + (size_t)i * 32 * 1024); }
  }
  auto put_stage = [&](char* kb) {
    char* vb = kb + 128 * KR;
#pragma unroll
    for (int i = 0; i < 4; ++i) {
      *(u32x4*)(kb + (krow + 32 * i) * KR + kpart * 16) = rk[i];
      *(u32x4*)(vb + (krow + 32 * i) * VR + kpart * 16) = rv[i];
    }
  };
  auto get_stage = [&](int st) {
    const int k0 = st * 128;
#pragma unroll
    for (int i = 0; i < 4; ++i) { rk[i] = *(const u32x4*)(gk + (size_t)(k0 + i * 32) * 1024); rv[i] = *(const u32x4*)(gv + (size_t)(k0 + i * 32) * 1024); }
  };
  if (!pre) put_stage(smem);
  __syncthreads();
  get_stage(1);
  for (int kt = 0; kt < 32; ++kt) {
    const char* ks = smem + (kt & 1) * STG; const char* vs = ks + 128 * KR;
#pragma unroll
    for (int sub = 0; sub < 2; ++sub) {
      const int kbase = kt * 128 + sub * 64;
      const int relmin = kbase - (qb * 128 + 127), relmax = kbase + 63 - qb * 128;
      const float cb = (relmin >= 128) ? cR : ((relmax <= -128) ? cL : 0.f);
      f32x16 s0, s1;
#pragma unroll
      for (int i = 0; i < 16; ++i) { s0[i] = cb - m; s1[i] = cb - m; }
      {
        bf16x8 kf[8];
#pragma unroll
        for (int s = 0; s < 4; ++s) {
          kf[2 * s] = *(const bf16x8*)(ks + (sub * 64 + r32) * KR + (map * 64 + s * 16 + hh * 8) * 2);
          kf[2 * s + 1] = *(const bf16x8*)(ks + (sub * 64 + 32 + r32) * KR + (map * 64 + s * 16 + hh * 8) * 2);
        }
        __builtin_amdgcn_sched_barrier(0); __builtin_amdgcn_s_setprio(1);
#pragma unroll
        for (int s = 0; s < 4; ++s) { s0 = mfma32(kf[2 * s], qf[s], s0); s1 = mfma32(kf[2 * s + 1], qf[s], s1); }
      __builtin_amdgcn_s_setprio(0);
}
      if (relmin < 128 && relmax > -128) {
        const int base = kbase - qpos + 255 + 4 * hh;
#pragma unroll
        for (int i = 0; i < 16; ++i) {
          int i0 = base + (i & 3) + 8 * (i >> 2);
          int i1 = i0 + 32;
          i0 = i0 < 0 ? 0 : (i0 > 510 ? 510 : i0);
          i1 = i1 < 0 ? 0 : (i1 > 510 ? 510 : i1);
          s0[i] += tab[i0]; s1[i] += tab[i1];
        }
      }
      float alpha; bf16x8 pf[4];
      const bool resc = softmax_tile(s0, s1, m, l, alpha, pf, lane, (kt == 0) && (sub == 0), (sub == 0) && ((kt & 3) == 0));
      {
        bf16x8 vf[2][4];
#pragma unroll
        for (int j = 0; j < 4; ++j) vf[0][j] = ld_vfrag_tr(vs, vbase, VR, sub * 64, j * 32);
#pragma unroll
        for (int s = 0; s < 4; ++s) {
          if (s < 3) {
#pragma unroll
            for (int j = 0; j < 4; ++j) vf[(s + 1) & 1][j] = ld_vfrag_tr(vs, vbase, VR, sub * 64 + 16 * (s + 1), j * 32);
          }
          __builtin_amdgcn_sched_barrier(0); __builtin_amdgcn_s_setprio(1);
#pragma unroll
          for (int j = 0; j < 4; ++j) O[j] = mfma32(vf[s & 1][j], pf[s], O[j]);
        __builtin_amdgcn_s_setprio(0);
}
      }
      if (resc) {
#pragma unroll
        for (int j = 0; j < 4; ++j) scale16(O[j], alpha);
      }
    }
    if (kt + 1 < 32) put_stage(smem + ((kt + 1) & 1) * STG);
    else if (has_next) put_stage(smem);
    __syncthreads();
    if (kt + 2 < 32) get_stage(kt + 2);
    else if (kt == 30 && has_next) { gk += (nh - h) * 128; gv += (nh - h) * 128; get_stage(0); }
  }
  const float lt = l + shx(l, 32, lane);
  const float inv = 1.f / lt;
  float* xch = (float*)(smem + STG);
  if (map == 1) {
#pragma unroll
    for (int j = 0; j < 4; ++j)
#pragma unroll
      for (int i = 0; i < 16; ++i) xch[(rg * 64 + j * 16 + i) * 64 + lane] = O[j][i] * inv;
  }
  __syncthreads();
  if (map == 0) {
    const float lam = ((const float*)(p.ws + TB_LAM))[li];
    const int layer = 2 * li + 1;
    const float linit = 0.8f - 0.6f * expf(-0.3f * (float)layer);
    float ss = 0.f;
#pragma unroll
    for (int j = 0; j < 4; ++j)
#pragma unroll
      for (int i = 0; i < 16; ++i) {
        float v = O[j][i] * inv - lam * xch[(rg * 64 + j * 16 + i) * 64 + lane];
        O[j][i] = v; ss += v * v;
      }
    ss += shx(ss, 32, lane);
    const float rinv = rsqrtf(ss * (1.f / 128.f) + EPS) * (1.f - linit);
    const float* sub = p.c_subln + li * 128;
    u16* op = o + (size_t)qrow * 1024 + h * 128 + 4 * hh;
#pragma unroll
    for (int j = 0; j < 4; ++j)
#pragma unroll
      for (int i4 = 0; i4 < 4; ++i4) {
        const int dv = j * 32 + 8 * i4 + 4 * hh;
        const f32x4 g4 = *(const f32x4*)(sub + dv);
        f32x4 v = {O[j][4 * i4] * g4[0], O[j][4 * i4 + 1] * g4[1], O[j][4 * i4 + 2] * g4[2], O[j][4 * i4 + 3] * g4[3]};
        st_bf4(op + j * 32 + 8 * i4, v, rinv);
      }
  }
}

#define XB_TMO      128
#define XB_XCNT(j)  (256  + 64 * (j))
#define XB_XSUB(j)  (1280 + 64 * (j))
#define XB_XGEN(j)  (2304 + 64 * (j))
#define XB_TOP      3328
#define XB_TOPGEN   3392
#define XCD_BAR_WORDS 3456
#define XB_SPIN_CAP (1u << 18)
DI unsigned xb_ld(unsigned* p)              { return __hip_atomic_load(p, __ATOMIC_RELAXED, __HIP_MEMORY_SCOPE_AGENT); }
DI unsigned xb_add(unsigned* p, unsigned v) { return __hip_atomic_fetch_add(p, v, __ATOMIC_RELAXED, __HIP_MEMORY_SCOPE_AGENT); }
DI unsigned xb_xcc_id() { return (unsigned)__builtin_amdgcn_s_getreg((3 << 11) | 20) & 0xFu; }
#define XB_SPIN(cond, bar) do { unsigned _sp = 0; while (cond) { __builtin_amdgcn_s_sleep(1); \
    if ((++_sp & 255u) == 0u) { if (xb_ld(&(bar)[XB_TMO])) break; if (_sp > XB_SPIN_CAP) { atomicAdd(&(bar)[XB_TMO], 1u); break; } } } } while (0)
struct XcdBarrier { unsigned* bar; unsigned x; volatile LAS unsigned* st; };
DI XcdBarrier xcd_barrier_post(unsigned* bar, volatile LAS unsigned* st) {
  XcdBarrier b; b.bar = bar; b.x = xb_xcc_id(); b.st = st;
  if (threadIdx.x == 0) (void)xb_add(&bar[XB_XCNT(b.x)], 1u);
  return b;
}
DI void xcd_barrier_complete(unsigned* bar, unsigned x, unsigned& nloc, unsigned& nx) {
  const unsigned G = gridDim.x * gridDim.y * gridDim.z;
  unsigned sum, cnt, mine, sp = 0u;
  for (;;) {
    sum = 0u; cnt = 0u; mine = 0u;
#pragma unroll
    for (unsigned j = 0; j < 16; ++j) { const unsigned c = xb_ld(&bar[XB_XCNT(j)]); sum += c; cnt += (c > 0u) ? 1u : 0u; mine = (j == x) ? c : mine; }
    if (sum == G) break;
    __builtin_amdgcn_s_sleep(1);
    if ((++sp & 255u) == 0u) { if (xb_ld(&bar[XB_TMO])) break; if (sp > XB_SPIN_CAP) { atomicAdd(&bar[XB_TMO], 1u); break; } }
  }
  nloc = mine > 0u ? mine : 1u; nx = cnt > 0u ? cnt : 1u;
}
DI void xcd_barrier(const XcdBarrier& b) {
  asm volatile("s_waitcnt vmcnt(0)" ::: "memory");
  __syncthreads();
  if (threadIdx.x == 0) {
    size_t zb = 0; asm volatile("" : "+s"(zb));
    unsigned* bar = b.bar + zb;
    __builtin_amdgcn_s_waitcnt(0);
    unsigned nloc = b.st[0], nx = b.st[1];
    if (nloc == 0u) { xcd_barrier_complete(bar, b.x, nloc, nx); b.st[0] = nloc; b.st[1] = nx; }
    const unsigned old = xb_add(&bar[XB_XSUB(b.x)], 1u);
    const unsigned gen = old / nloc;
    if (old + 1u == (gen + 1u) * nloc) {
      __builtin_amdgcn_fence(__ATOMIC_RELEASE, "agent");
      asm volatile("s_waitcnt vmcnt(0)" ::: "memory");
      const unsigned og = xb_add(&bar[XB_TOP], 1u);
      const unsigned tg = og / nx;
      if (og + 1u == (tg + 1u) * nx) xb_add(&bar[XB_TOPGEN], 1u);
      else XB_SPIN(xb_ld(&bar[XB_TOPGEN]) == tg, bar);
      __builtin_amdgcn_fence(__ATOMIC_ACQUIRE, "agent");
      xb_add(&bar[XB_XGEN(b.x)], 1u);
      asm volatile("s_waitcnt vmcnt(0)" ::: "memory");
    } else {
      XB_SPIN(xb_ld(&bar[XB_XGEN(b.x)]) == gen, bar);
      __builtin_amdgcn_fence(__ATOMIC_ACQUIRE, "agent");
      asm volatile("s_waitcnt vmcnt(0)" ::: "memory");
    }
  }
  __syncthreads();
}

#define LAUNDER(q)  Params q = p; { size_t zoff = 0; asm volatile("" : "+s"(zoff)); q.ws = p.ws + zoff; q.xres = p.xres + zoff; q.x = p.x + zoff; }
#define PH_BEGIN(n) if (ph_lo <= (n) && (n) < ph_hi) { LAUNDER(q); char* ws = q.ws; (void)ws;
#define PH_END(n)   if ((n) + 1 < ph_hi) { xcd_barrier(xb); } }

__global__ void __launch_bounds__(512) mega(Params p, int ph_lo, int ph_hi) {
  extern __shared__ __attribute__((aligned(16))) unsigned char lds_raw[];
  LAS unsigned char* lds = (LAS unsigned char*)lds_raw;
  char* smem = (char*)lds_raw;
  const int nx = gridDim.x >> 3, xcd = blockIdx.x & 7, jx = blockIdx.x >> 3;
  volatile LAS unsigned* bst = (volatile LAS unsigned*)(lds + SM_BARST);
  if (threadIdx.x < 2) bst[threadIdx.x] = 0u;
  __syncthreads();
  const XcdBarrier xb = xcd_barrier_post((unsigned*)(p.ws + TB_BAR), bst);

  if (ph_lo < 0) cg::this_grid().sync();
  PH_BEGIN(0) phase_prep(q, smem); PH_END(0)

#pragma unroll 1
  for (int L = 0; L < 4; ++L) {
    const int pb = 1 + 8 * L, li = L >> 1;
    const bool even = (L & 1) == 0;
    if (even) {
      PH_BEGIN(pb + 1)
        run_gemm<EPI_ABIN>(lds, (const u16*)(ws + B_XR), (const u16*)(ws + W_ABIN) + (size_t)li * 2304 * 1024, 2304, 1024, q, nullptr, (const float*)(ws + TB_SSA), nullptr);
      PH_END(pb + 1)
      PH_BEGIN(pb + 2)
        run_gemm<EPI_UQ>(lds, (const u16*)(ws + B_BIG + E_CQ), (const u16*)(ws + W_UQ) + (size_t)li * 768 * 384, 768, 384, q, nullptr, nullptr, nullptr);
        run_gemm<EPI_UKV>(lds, (const u16*)(ws + B_BIG + E_CKV), (const u16*)(ws + W_UKV) + (size_t)li * 1024 * 256, 1024, 256, q, nullptr, nullptr, nullptr);
      PH_END(pb + 2)
      PH_BEGIN(pb + 3)
        if (jx < nx) {
          const int half = get_tid() >> 8;
          char* sm = smem + half * ATT_HALF;
#pragma unroll 1
          for (int u = jx; u < 128; u += nx) attn_mla_unit(q, xcd, u >> 4, u & 15, smem, u != jx, (u + nx) >> 4, u + nx < 128);
#pragma unroll 1
          for (int up = jx; up < 128; up += nx) { const int u = 2 * up + half; attn_na_unit(q, li, xcd, u >> 2, u & 3, sm); }
        }
      PH_END(pb + 3)
    } else {
      PH_BEGIN(pb + 1)
        run_gemm<EPI_CIN>(lds, (const u16*)(ws + B_XR), (const u16*)(ws + W_CIN) + (size_t)li * 3072 * 1024, 3072, 1024, q, nullptr, (const float*)(ws + TB_SSA), nullptr);
      PH_END(pb + 1)
      PH_BEGIN(pb + 3)
        if (jx < nx) {
          const int half = get_tid() >> 8;
          char* sm = smem + half * ATT_HALF;
#pragma unroll 1
          for (int u = jx; u < 256; u += nx) attn_diff_unit(q, li, xcd, u >> 5, u & 31, smem, u != jx, (u + nx) >> 5, u + nx < 256);
        }
      PH_END(pb + 3)
    }
    PH_BEGIN(pb + 4)
      run_gemm<EPI_RESID>(lds, (const u16*)(ws + B_H), (const u16*)(ws + (even ? W_ABOUT : W_COUT)) + (size_t)li * 1024 * 1024, 1024, 1024, q, (L == 0) ? q.x : nullptr, nullptr, (float*)(ws + TB_SSM));
    PH_END(pb + 4)
    PH_BEGIN(pb + 6)
      run_gemm<EPI_RELU2>(lds, (const u16*)(ws + B_XR), (const u16*)(ws + W_W1) + (size_t)L * 4096 * 1024, 4096, 1024, q, nullptr, (const float*)(ws + TB_SSM), nullptr);
    PH_END(pb + 6)
    PH_BEGIN(pb + 7)
      run_gemm<EPI_RESID>(lds, (const u16*)(ws + B_BIG), (const u16*)(ws + W_W2) + (size_t)L * 1024 * 4096, 1024, 4096, q, nullptr, nullptr, (float*)(ws + TB_SSA));
    PH_END(pb + 7)
  }

  PH_BEGIN(NPH - 1) phase_norm<true, true>(ws + B_XR, q.final_norm, nullptr, q.xres); PH_END(NPH - 1)
}

extern "C" void kernel_launch(void* const* d_in, const int* in_sizes, int n_in, void* d_out, int out_size,
                              void* d_ws, size_t ws_size, hipStream_t stream) {
  if (ws_size < WS_NEED) { fprintf(stderr, "workspace too small: %zu < %zu\n", ws_size, WS_NEED); return; }
  Params p{};
  p.x = (const float*)d_in[0]; p.norm_attn = (const float*)d_in[1]; p.norm_mlp = (const float*)d_in[2];
  p.ab_w_in = (const float*)d_in[3]; p.ab_q_norm = (const float*)d_in[4]; p.ab_w_uq = (const float*)d_in[5];
  p.ab_kv_norm = (const float*)d_in[6]; p.ab_w_ukv = (const float*)d_in[7]; p.ab_rpb = (const float*)d_in[8];
  p.ab_w_out = (const float*)d_in[9]; p.c_w_in = (const float*)d_in[10]; p.lq1 = (const float*)d_in[11];
  p.lk1 = (const float*)d_in[12]; p.lq2 = (const float*)d_in[13]; p.lk2 = (const float*)d_in[14];
  p.c_subln = (const float*)d_in[15]; p.c_w_out = (const float*)d_in[16]; p.t5 = (const float*)d_in[17];
  p.mlp_w1 = (const float*)d_in[18]; p.mlp_w2 = (const float*)d_in[19]; p.final_norm = (const float*)d_in[20];
  p.xres = (float*)d_out; p.ws = (char*)d_ws;

  static int grid_blocks = 0;
  if (!grid_blocks) {
    int dev = 0, cus = 0, per_cu = 0;
    (void)hipGetDevice(&dev);
    (void)hipDeviceGetAttribute(&cus, hipDeviceAttributeMultiprocessorCount, dev);
    if (hipFuncSetAttribute((const void*)mega, hipFuncAttributeMaxDynamicSharedMemorySize, SMEM_BYTES) != hipSuccess) { fprintf(stderr, "hipFuncSetAttribute failed\n"); grid_blocks = -1; return; }
    (void)hipOccupancyMaxActiveBlocksPerMultiprocessor(&per_cu, mega, NTHR, SMEM_BYTES);
    (void)hipGetLastError();
    grid_blocks = cus;
  }
  if (grid_blocks < 0) return;
#if MULTI_LAUNCH
  for (int ph = 0; ph < NPH; ++ph) {
    if (ph >= 1 && ph < NPH - 1 && ((ph - 1) & 7) == 2 && ((((ph - 1) >> 3) & 1) == 1)) continue;
    hipLaunchKernelGGL(mega, dim3(grid_blocks), dim3(NTHR), SMEM_BYTES, stream, p, ph, ph + 1);
  }
#else
  (void)hipMemsetAsync((char*)d_ws + TB_BAR, 0, 16384, stream);
  int lo = 0, hi = NPH;
  void* args[] = {&p, &lo, &hi};
  hipError_t e = hipLaunchCooperativeKernel((void*)mega, dim3(grid_blocks), dim3(NTHR), args, SMEM_BYTES, stream);
  if (e != hipSuccess) fprintf(stderr, "cooperative launch failed: %s (grid %d)\n", hipGetErrorString(e), grid_blocks);
#endif
}
```
